# Optimizing an MI355X kernel written in HIP

```python
import jax
import jax.numpy as jnp
from jax import lax
import numpy as np

D_MODEL = 2048
BATCH = 2
SEQ = 8192
DEPTH = 4

N_HEADS = 32
HEAD_DIM = 64
SWA_KV_HEADS = 4
SWA_WINDOW = 128
Q_BLOCK = 128
NSA_KV_HEADS = 4
CMP_LEN = 32
CMP_STRIDE = 16
CMP_HIDDEN = 512
SEL_LEN = 64
SEL_TOPK = 16
NSA_WINDOW = 512
D_FF = 5632
CONV_WIDTH = 3
RMS_EPS = 1e-6
MASK_VALUE = -1e30
FORCE_VALUE = 1e30
N_MIXERS = 2
N_SWA_LAYERS = (DEPTH + 1) // 2
N_NSA_LAYERS = DEPTH // 2
SWA_IN = N_HEADS * HEAD_DIM + 2 * SWA_KV_HEADS * HEAD_DIM
NSA_IN = N_HEADS * HEAD_DIM + 6 * NSA_KV_HEADS * HEAD_DIM + 3 * N_HEADS
F32 = jnp.float32

kernel_name = 'hybrid_swa_sink_nsa_convffn'


def rmsnorm(x, g):
    xf = x.astype(F32)
    y = xf * lax.rsqrt(jnp.mean(xf * xf, axis=-1, keepdims=True) + RMS_EPS)
    return (y * g.astype(F32)).astype(x.dtype)


def alibi_slopes(n):
    return jnp.exp2(-8.0 * jnp.arange(1, n + 1, dtype=F32) / n)


def masked_softmax(s, valid):
    s = jnp.where(valid, s, MASK_VALUE)
    m = jnp.max(s, axis=-1, keepdims=True)
    e = jnp.where(valid, jnp.exp(s - m), 0.0)
    return e / jnp.maximum(jnp.sum(e, axis=-1, keepdims=True), 1e-30)


def swa_sink_attention(h, w_in, b_in, sinks, w_o, b_o):
    B, S, _ = h.shape
    G = N_HEADS // SWA_KV_HEADS
    nb = S // Q_BLOCK
    proj = h @ w_in + b_in
    q, k, v = jnp.split(proj, [N_HEADS * HEAD_DIM, (N_HEADS + SWA_KV_HEADS) * HEAD_DIM], axis=-1)
    q = q.reshape(B, nb, Q_BLOCK, SWA_KV_HEADS, G, HEAD_DIM).astype(F32) * HEAD_DIM ** -0.5
    k = k.reshape(B, nb, Q_BLOCK, SWA_KV_HEADS, HEAD_DIM).astype(F32)
    v = v.reshape(B, nb, Q_BLOCK, SWA_KV_HEADS, HEAD_DIM).astype(F32)

    def with_prev(t):
        prev = jnp.pad(t[:, :-1], ((0, 0), (1, 0), (0, 0), (0, 0), (0, 0)))
        return jnp.concatenate([prev, t], axis=2)

    kk, vv = with_prev(k), with_prev(v)
    s = jnp.einsum('bnqkgd,bnskd->bnkgqs', q, kk)
    dist = Q_BLOCK + jnp.arange(Q_BLOCK)[:, None] - jnp.arange(2 * Q_BLOCK)[None, :]
    band = (dist >= 0) & (dist < SWA_WINDOW)
    key_pos = jnp.arange(nb)[:, None] * Q_BLOCK - Q_BLOCK + jnp.arange(2 * Q_BLOCK)[None, :]
    valid = band[None] & (key_pos >= 0)[:, None, :]
    slopes = alibi_slopes(N_HEADS).reshape(SWA_KV_HEADS, G)
    s = s - slopes[:, :, None, None] * dist.astype(F32)
    s = jnp.where(valid[:, None, None], s, MASK_VALUE)
    sink = sinks.astype(F32).reshape(SWA_KV_HEADS, G)[:, :, None]
    m = jnp.maximum(jnp.max(s, axis=-1), sink)
    e = jnp.exp(s - m[..., None])
    p = e / (jnp.sum(e, axis=-1, keepdims=True) + jnp.exp(sink - m)[..., None])
    o = jnp.einsum('bnkgqs,bnskd->bnqkgd', p, vv).reshape(B, S, N_HEADS * HEAD_DIM).astype(h.dtype)
    return o @ w_o + b_o


def compress_blocks(kv, pe, w1, b1, w2, b2):
    B, S, G, Dh = kv.shape
    n_cmp = (S - CMP_LEN) // CMP_STRIDE + 1
    idx = jnp.arange(n_cmp)[:, None] * CMP_STRIDE + jnp.arange(CMP_LEN)[None, :]
    blk = kv[:, idx] + pe[None, None, :, None, :]
    blk = blk.transpose(0, 1, 3, 2, 4).reshape(B, n_cmp, G, CMP_LEN * Dh)
    return jax.nn.gelu(blk @ w1 + b1) @ w2 + b2


def cmp_sel_overlap(S):
    n_cmp = (S - CMP_LEN) // CMP_STRIDE + 1
    cs = np.arange(n_cmp) * CMP_STRIDE
    ss = np.arange(S // SEL_LEN) * SEL_LEN
    ov = (cs[:, None] < ss[None, :] + SEL_LEN) & (cs[:, None] + CMP_LEN > ss[None, :])
    return jnp.asarray(ov.astype(np.float32))


def nsa_attention(h, w_in, cmp_pe, cmp_w1, cmp_b1, cmp_w2, cmp_b2, w_o):
    B, S, _ = h.shape
    G = NSA_KV_HEADS
    R = N_HEADS // G
    HD = N_HEADS * HEAD_DIM
    KD = G * HEAD_DIM
    proj = h @ w_in
    splits = [HD + i * KD for i in range(7)]
    q, kc, vc, ks, vs, kw, vw, gate = jnp.split(proj, splits, axis=-1)
    q = q.reshape(B, S, G, R, HEAD_DIM).astype(F32) * HEAD_DIM ** -0.5

    def to_kv(t):
        return t.reshape(B, S, G, HEAD_DIM)

    k_cmp = compress_blocks(to_kv(kc), cmp_pe[0], cmp_w1[0], cmp_b1[0], cmp_w2[0], cmp_b2[0]).astype(F32)
    v_cmp = compress_blocks(to_kv(vc), cmp_pe[1], cmp_w1[1], cmp_b1[1], cmp_w2[1], cmp_b2[1]).astype(F32)
    n_cmp = k_cmp.shape[1]
    cmp_end = jnp.arange(n_cmp) * CMP_STRIDE + CMP_LEN - 1
    overlap = cmp_sel_overlap(S)
    n_sel = S // SEL_LEN
    topk = min(SEL_TOPK, n_sel)
    k_sel = to_kv(ks).astype(F32).reshape(B, n_sel, SEL_LEN, G, HEAD_DIM).transpose(0, 3, 1, 2, 4)
    v_sel = to_kv(vs).astype(F32).reshape(B, n_sel, SEL_LEN, G, HEAD_DIM).transpose(0, 3, 1, 2, 4)
    pad = ((0, 0), (NSA_WINDOW, 0), (0, 0), (0, 0))
    k_win = jnp.pad(to_kv(kw).astype(F32), pad)
    v_win = jnp.pad(to_kv(vw).astype(F32), pad)
    gates = jax.nn.sigmoid(gate.astype(F32)).reshape(B, S, G, R, 3)
    slopes = alibi_slopes(N_HEADS).reshape(G, R)
    bi = jnp.arange(B)[:, None, None, None]
    gi = jnp.arange(G)[None, :, None, None]
    sel_ids = jnp.arange(n_sel)
    sel_off = jnp.arange(SEL_LEN)
    win_off = jnp.arange(Q_BLOCK + NSA_WINDOW)
    q_idx = jnp.arange(Q_BLOCK)

    def query_block(c):
        t0 = c * Q_BLOCK
        t = t0 + q_idx
        qc = lax.dynamic_slice_in_dim(q, t0, Q_BLOCK, axis=1)
        gc = lax.dynamic_slice_in_dim(gates, t0, Q_BLOCK, axis=1)
        d_cmp = t[:, None] - cmp_end[None, :]
        s = jnp.einsum('bqgrd,bngd->bgrqn', qc, k_cmp) - slopes[:, :, None, None] * d_cmp.astype(F32)
        p_cmp = masked_softmax(s, d_cmp >= 0)
        o_cmp = jnp.einsum('bgrqn,bngd->bqgrd', p_cmp, v_cmp)
        imp = jnp.einsum('bgrqn,nj->bgqj', p_cmp, overlap)
        cur = t // SEL_LEN
        causal = sel_ids[None, :] <= cur[:, None]
        forced = (sel_ids[None, :] == 0) | (sel_ids[None, :] == cur[:, None]) | (sel_ids[None, :] == cur[:, None] - 1)
        score = jnp.where(forced, FORCE_VALUE, jnp.where(causal, imp, MASK_VALUE))
        _, top = lax.top_k(score, topk)
        kg = k_sel[bi, gi, top].reshape(B, G, Q_BLOCK, topk * SEL_LEN, HEAD_DIM)
        vg = v_sel[bi, gi, top].reshape(B, G, Q_BLOCK, topk * SEL_LEN, HEAD_DIM)
        pos = (top[..., None] * SEL_LEN + sel_off).reshape(B, G, Q_BLOCK, topk * SEL_LEN)
        blk_ok = jnp.repeat(top <= cur[None, None, :, None], SEL_LEN, axis=-1)
        d_sel = t[None, None, :, None] - pos
        valid_sel = (d_sel >= 0) & blk_ok
        s = jnp.einsum('bqgrd,bgqsd->bgrqs', qc, kg) - slopes[None, :, :, None, None] * d_sel[:, :, None].astype(F32)
        p = masked_softmax(s, valid_sel[:, :, None])
        o_sel = jnp.einsum('bgrqs,bgqsd->bqgrd', p, vg)
        kwc = lax.dynamic_slice_in_dim(k_win, t0, Q_BLOCK + NSA_WINDOW, axis=1)
        vwc = lax.dynamic_slice_in_dim(v_win, t0, Q_BLOCK + NSA_WINDOW, axis=1)
        d_win = q_idx[:, None] + NSA_WINDOW - win_off[None, :]
        key_pos = t0 - NSA_WINDOW + win_off
        valid_win = (d_win >= 0) & (d_win < NSA_WINDOW) & (key_pos >= 0)[None, :]
        s = jnp.einsum('bqgrd,bsgd->bgrqs', qc, kwc) - slopes[:, :, None, None] * d_win.astype(F32)
        p = masked_softmax(s, valid_win)
        o_win = jnp.einsum('bgrqs,bsgd->bqgrd', p, vwc)
        o = gc[..., 0:1] * o_cmp + gc[..., 1:2] * o_sel + gc[..., 2:3] * o_win
        return o.reshape(B, Q_BLOCK, HD)

    out = lax.map(query_block, jnp.arange(S // Q_BLOCK))
    out = out.transpose(1, 0, 2, 3).reshape(B, S, HD).astype(h.dtype)
    return out @ w_o


def causal_dwconv(a, w, b):
    S = a.shape[1]
    ap = jnp.pad(a, ((0, 0), (CONV_WIDTH - 1, 0), (0, 0)))
    y = b + ap[:, 0:S] * w[0]
    for kk in range(1, CONV_WIDTH):
        y = y + ap[:, kk:kk + S] * w[kk]
    return y


def conv_ffn(h, w_gate, w_up, conv_w, conv_b, w_down):
    a = causal_dwconv(h @ w_gate, conv_w, conv_b)
    return (jax.nn.silu(a) * (h @ w_up)) @ w_down


def setup_inputs(seed: int = 0) -> dict:
    key = jax.random.key(seed)
    ks = iter(jax.random.split(key, 32))

    def rnd(shape, scale):
        return jax.random.normal(next(ks), shape, jnp.float32) * scale

    HD = N_HEADS * HEAD_DIM
    return {
        'x': rnd((BATCH, SEQ, D_MODEL), 1.0),
        'norm_g': 1.0 + rnd((DEPTH, 4, D_MODEL), 0.02),
        'swa_w_in': rnd((N_SWA_LAYERS, D_MODEL, SWA_IN), D_MODEL ** -0.5),
        'swa_b_in': rnd((N_SWA_LAYERS, SWA_IN), 0.02),
        'swa_sinks': rnd((N_SWA_LAYERS, N_HEADS), 0.5),
        'swa_w_o': rnd((N_SWA_LAYERS, HD, D_MODEL), HD ** -0.5),
        'swa_b_o': rnd((N_SWA_LAYERS, D_MODEL), 0.02),
        'nsa_w_in': rnd((N_NSA_LAYERS, D_MODEL, NSA_IN), D_MODEL ** -0.5),
        'nsa_cmp_pe': rnd((N_NSA_LAYERS, 2, CMP_LEN, HEAD_DIM), 0.1),
        'nsa_cmp_w1': rnd((N_NSA_LAYERS, 2, CMP_LEN * HEAD_DIM, CMP_HIDDEN), (CMP_LEN * HEAD_DIM) ** -0.5),
        'nsa_cmp_b1': rnd((N_NSA_LAYERS, 2, CMP_HIDDEN), 0.02),
        'nsa_cmp_w2': rnd((N_NSA_LAYERS, 2, CMP_HIDDEN, HEAD_DIM), CMP_HIDDEN ** -0.5),
        'nsa_cmp_b2': rnd((N_NSA_LAYERS, 2, HEAD_DIM), 0.02),
        'nsa_w_o': rnd((N_NSA_LAYERS, HD, D_MODEL), HD ** -0.5),
        'ffn_w_gate': rnd((DEPTH, D_MODEL, D_FF), D_MODEL ** -0.5),
        'ffn_w_up': rnd((DEPTH, D_MODEL, D_FF), D_MODEL ** -0.5),
        'ffn_conv_w': rnd((DEPTH, CONV_WIDTH, D_FF), CONV_WIDTH ** -0.5),
        'ffn_conv_b': rnd((DEPTH, D_FF), 0.02),
        'ffn_w_down': rnd((DEPTH, D_FF, D_MODEL), D_FF ** -0.5),
    }


def reference(x, norm_g, swa_w_in, swa_b_in, swa_sinks, swa_w_o, swa_b_o,
              nsa_w_in, nsa_cmp_pe, nsa_cmp_w1, nsa_cmp_b1, nsa_cmp_w2, nsa_cmp_b2, nsa_w_o,
              ffn_w_gate, ffn_w_up, ffn_conv_w, ffn_conv_b, ffn_w_down):
    for i in range(DEPTH):
        g = norm_g[i]
        h = rmsnorm(x, g[0])
        j = i // N_MIXERS
        if i % N_MIXERS == 0:
            mix = swa_sink_attention(h, swa_w_in[j], swa_b_in[j], swa_sinks[j], swa_w_o[j], swa_b_o[j])
        else:
            mix = nsa_attention(h, nsa_w_in[j], nsa_cmp_pe[j], nsa_cmp_w1[j], nsa_cmp_b1[j],
                                nsa_cmp_w2[j], nsa_cmp_b2[j], nsa_w_o[j])
        x = x + rmsnorm(mix, g[1])
        h = rmsnorm(x, g[2])
        x = x + rmsnorm(conv_ffn(h, ffn_w_gate[i], ffn_w_up[i], ffn_conv_w[i], ffn_conv_b[i], ffn_w_down[i]), g[3])
    return x
```

```cpp
#include <hip/hip_runtime.h>
#include <hip/hip_cooperative_groups.h>
#include <cstdio>
#include <cstdint>
namespace cg = cooperative_groups;
namespace pg8 {
#define PG8_LAS __attribute__((address_space(3)))
typedef unsigned short bf16_t;
typedef short bf16x8 __attribute__((ext_vector_type(8)));
typedef float f32x4 __attribute__((ext_vector_type(4)));
typedef unsigned u32x4 __attribute__((ext_vector_type(4)));
constexpr int BM = 256, BK = 64, HALF = 128, HTB = HALF * BK * 2  , STAGE_BYTES = 8 * HTB, NXCD = 8, WGM = 8;

__host__ __device__ __forceinline__ int lds_byte(int r, int c) { const int st = (r >> 4) * 2 + (c >> 5), rr = r & 15, cc = c & 31, ob = rr * 64 + cc * 2; return st * 1024 + (ob ^ (((ob >> 9) & 1) << 5)); }
__host__ __device__ __forceinline__ void stage_rc(int b, int& R, int& C) { const int st = b / 1024, sb = b % 1024, swz = sb ^ (((sb >> 9) & 1) << 5); R = (st >> 1) * 16 + swz / 64; C = (st & 1) * 32 + (swz % 64) / 2; }
__host__ __device__ __forceinline__ int perm32(int rho) { const int n = rho >> 4, i = rho & 15; return 8 * (i >> 2) + 4 * n + (i & 3); }

struct Unit { int pm, pn; };
struct Gemm { const bf16_t* A; const bf16_t* Bt; int M, N, K; };

struct StaticOrder {
    int nM, nN, nwg, G, c;
    __host__ __device__ void init(int M, int N, int G_, int c_) { nM = M / BM; nN = N / BM; nwg = nM * nN; G = G_; c = c_; }
    __host__ __device__ bool next(int i, Unit& u) const {
        const long L = (long)i * G + c; if (L >= nwg) return false;
        int wgid = (int)L; { const int q = nwg / NXCD, r = nwg % NXCD, xcd = wgid % NXCD, off = wgid / NXCD; wgid = (xcd < r ? xcd * (q + 1) : r * (q + 1) + (xcd - r) * q) + off; }
        const int nig = WGM * nN, gid = wgid / nig, fm = gid * WGM, gsz = (nM - fm) < WGM ? (nM - fm) : WGM;
        u.pm = fm + ((wgid % nig) % gsz); u.pn = (wgid % nig) / gsz; return true;
    }
    __device__ __forceinline__ void a_ready(const Unit&) const {}
    __device__ __forceinline__ void done(const Unit&) const {}
};

__device__ __forceinline__ unsigned cvt_pk_bf16(float lo, float hi) { unsigned r; asm volatile("v_cvt_pk_bf16_f32 %0, %1, %2" : "=v"(r) : "v"(lo), "v"(hi)); return r; }
__device__ __forceinline__ float gelu_tanh(float x) { const float u = 0.7978845608028654f * (x + 0.044715f * x * x * x); return x * __builtin_amdgcn_rcpf(1.0f + __builtin_amdgcn_exp2f(-2.0f * 1.4426950408889634f * u)); }
template <int ACT> struct EpiBf16 {
    static constexpr bool PERM = true, AFTER_DRAIN = false;
    bf16_t* O; int ldc; const float* bias;
    __device__ __forceinline__ void operator()(const f32x4 (&acc)[2][2][4][2], const Unit& u, int wr, int wc, int fr, int fq) const {
        const int row0 = u.pm * BM + wr * 64 + fr; const int col0 = u.pn * BM + wc * 32 + 8 * fq;
        f32x4 bv[2][2];
#pragma unroll
        for (int bj = 0; bj < 2; ++bj)
#pragma unroll
            for (int n = 0; n < 2; ++n) bv[bj][n] = bias ? *(const f32x4*)(bias + col0 + bj * HALF + 4 * n) : (f32x4){0.f, 0.f, 0.f, 0.f};
#pragma unroll
        for (int ai = 0; ai < 2; ++ai)
#pragma unroll
            for (int m = 0; m < 4; ++m) { bf16_t* rowp = O + (size_t)(row0 + ai * HALF + m * 16) * ldc + col0;
#pragma unroll
                for (int bj = 0; bj < 2; ++bj) { f32x4 v0 = acc[ai][bj][m][0] + bv[bj][0], v1 = acc[ai][bj][m][1] + bv[bj][1];
                    if (ACT == 2) { v0 = (f32x4){gelu_tanh(v0[0]), gelu_tanh(v0[1]), gelu_tanh(v0[2]), gelu_tanh(v0[3])}; v1 = (f32x4){gelu_tanh(v1[0]), gelu_tanh(v1[1]), gelu_tanh(v1[2]), gelu_tanh(v1[3])}; }
                    u32x4 w; w.x = cvt_pk_bf16(v0[0], v0[1]); w.y = cvt_pk_bf16(v0[2], v0[3]); w.z = cvt_pk_bf16(v1[0], v1[1]); w.w = cvt_pk_bf16(v1[2], v1[3]);
                    *(u32x4*)(rowp + bj * HALF) = w; } }
    }
};
struct EpiF32 {
    static constexpr bool PERM = false, AFTER_DRAIN = false;
    float* O; int ldc; const float* bias;
    __device__ __forceinline__ void operator()(const f32x4 (&acc)[2][2][4][2], const Unit& u, int wr, int wc, int fr, int fq) const {
        const int row0 = u.pm * BM + wr * 64 + fr; const int col0 = u.pn * BM + wc * 32 + 4 * fq;
        f32x4 bv[2][2];
#pragma unroll
        for (int bj = 0; bj < 2; ++bj)
#pragma unroll
            for (int n = 0; n < 2; ++n) bv[bj][n] = bias ? *(const f32x4*)(bias + col0 + bj * HALF + 16 * n) : (f32x4){0.f, 0.f, 0.f, 0.f};
#pragma unroll
        for (int ai = 0; ai < 2; ++ai)
#pragma unroll
            for (int m = 0; m < 4; ++m) { float* rowp = O + (size_t)(row0 + ai * HALF + m * 16) * ldc + col0;
#pragma unroll
                for (int bj = 0; bj < 2; ++bj)
#pragma unroll
                    for (int n = 0; n < 2; ++n) *(f32x4*)(rowp + bj * HALF + 16 * n) = acc[ai][bj][m][n] + bv[bj][n]; }
    }
};

__device__ __forceinline__ float dpp_f(float oldv, float src, const int ctrl_sel) {
    const int o = __builtin_bit_cast(int, oldv), s = __builtin_bit_cast(int, src); int r;
    if (ctrl_sel == 0) r = __builtin_amdgcn_update_dpp(o, s, 0x121, 0xF, 0xF, false);
    else if (ctrl_sel == 1) r = __builtin_amdgcn_update_dpp(o, s, 0x111, 0xF, 0xF, false);
    else if (ctrl_sel == 2) r = __builtin_amdgcn_update_dpp(o, s, 0x122, 0xF, 0xF, false);
    else r = __builtin_amdgcn_update_dpp(o, s, 0x112, 0xF, 0xF, false);
    return __builtin_bit_cast(float, r);
}
struct EpiAct {
    static constexpr bool PERM = true, AFTER_DRAIN = false;
    bf16_t* ACT; int dff; const float* cw; const float* cb; bf16_t* SBG0; bf16_t* SBU0; bf16_t* SBG1;
    __device__ __forceinline__ void operator()(const f32x4 (&acc)[2][2][4][2], const Unit& u, int wr, int wc, int fr, int fq) const {
        const int f0 = u.pn * HALF + wc * 32 + 8 * fq;
        float w0[8], w1[8], w2[8], bb[8];
#pragma unroll
        for (int h = 0; h < 2; ++h) { const f32x4 a0 = *(const f32x4*)(cw + f0 + 4 * h), a1 = *(const f32x4*)(cw + dff + f0 + 4 * h), a2 = *(const f32x4*)(cw + 2 * dff + f0 + 4 * h), a3 = *(const f32x4*)(cb + f0 + 4 * h);
#pragma unroll
            for (int e = 0; e < 4; ++e) { w0[4 * h + e] = a0[e]; w1[4 * h + e] = a1[e]; w2[4 * h + e] = a2[e]; bb[4 * h + e] = a3[e]; } }
#pragma unroll
        for (int ai = 0; ai < 2; ++ai) {
            const int grp = u.pm * 4 + ai * 2 + wr;
            float pg[8];
#pragma unroll
            for (int e = 0; e < 8; ++e) pg[e] = 0.f;
#pragma unroll
            for (int m = 0; m < 4; ++m) {
                float g[8], up[8], o[8];
#pragma unroll
                for (int e = 0; e < 8; ++e) { g[e] = acc[ai][0][m][e >> 2][e & 3]; up[e] = acc[ai][1][m][e >> 2][e & 3]; }
#pragma unroll
                for (int e = 0; e < 8; ++e) {
                    const float t1 = dpp_f(0.f, pg[e], 0); const float g1 = dpp_f(t1, g[e], 1);
                    const float t2 = dpp_f(0.f, pg[e], 2); const float g2 = dpp_f(t2, g[e], 3);
                    const float av = bb[e] + w0[e] * g2 + w1[e] * g1 + w2[e] * g[e];
                    o[e] = av * __builtin_amdgcn_rcpf(1.0f + __builtin_amdgcn_exp2f(-1.4426950408889634f * av)) * up[e];
                }
                const int row = u.pm * BM + ai * HALF + wr * 64 + m * 16 + fr;
                u32x4 ov; ov.x = cvt_pk_bf16(o[0], o[1]); ov.y = cvt_pk_bf16(o[2], o[3]); ov.z = cvt_pk_bf16(o[4], o[5]); ov.w = cvt_pk_bf16(o[6], o[7]);
                *(u32x4*)(ACT + (size_t)row * dff + f0) = ov;
                if (m == 0 && fr < 2) {
                    u32x4 gv; gv.x = cvt_pk_bf16(g[0], g[1]); gv.y = cvt_pk_bf16(g[2], g[3]); gv.z = cvt_pk_bf16(g[4], g[5]); gv.w = cvt_pk_bf16(g[6], g[7]);
                    u32x4 uv; uv.x = cvt_pk_bf16(up[0], up[1]); uv.y = cvt_pk_bf16(up[2], up[3]); uv.z = cvt_pk_bf16(up[4], up[5]); uv.w = cvt_pk_bf16(up[6], up[7]);
                    *(u32x4*)(SBG0 + (size_t)(grp * 2 + fr) * dff + f0) = gv; *(u32x4*)(SBU0 + (size_t)(grp * 2 + fr) * dff + f0) = uv;
                }
                if (m == 3 && fr >= 14) {
                    u32x4 gv; gv.x = cvt_pk_bf16(g[0], g[1]); gv.y = cvt_pk_bf16(g[2], g[3]); gv.z = cvt_pk_bf16(g[4], g[5]); gv.w = cvt_pk_bf16(g[6], g[7]);
                    *(u32x4*)(SBG1 + (size_t)(grp * 2 + fr - 14) * dff + f0) = gv;
                }
#pragma unroll
                for (int e = 0; e < 8; ++e) pg[e] = g[e];
            }
        }
    }
};
template <class Epi, class Sched, bool ALIGN_EPI = false, bool SP2 = false>
__device__ __forceinline__ void gemm_phase(PG8_LAS unsigned char* lds, const Gemm g, const Sched& S, const Epi& E, const int tid) {
    const int wid = __builtin_amdgcn_readfirstlane(tid >> 6), lane = tid & 63, wr = wid >> 2, wc = wid & 3, fr = lane & 15, fq = lane >> 4;
    const int K = g.K, nt = K / BK;
    unsigned voffA[2], voffB[2];
#pragma unroll
    for (int i = 0; i < 2; ++i) { int R, C; stage_rc(tid * 16 + i * 8192, R, C); const int Rb = Epi::PERM ? ((R & ~31) + perm32(R & 31)) : R;
        voffA[i] = (unsigned)(R * K + C) * 2u; voffB[i] = (unsigned)(Rb * K + C) * 2u; }
    const size_t kstep = (size_t)(BK * 2);
    const size_t hstep = (size_t)HALF * K * 2;
    const size_t tstep = 2 * hstep;
    const unsigned ldsw = (unsigned)wid * 1024u;
    const int aoff = lds_byte(wr * 64 + fr, fq * 8), boff = lds_byte(wc * 32 + fr, fq * 8);
#define PG8_SA(b, h) (((b) * 2 + (h)) * HTB)
#define PG8_SB(b, h) ((4 + (b) * 2 + (h)) * HTB)
#define PG8_STAGE(bufoff, gbase, voff) do { _Pragma("unroll") for (int _i = 0; _i < 2; ++_i) \
        __builtin_amdgcn_global_load_lds((const unsigned*)((const char*)(gbase) + (voff)[_i]), (PG8_LAS unsigned*)(lds + (bufoff) + ldsw + _i * 8192), 16, 0, 0); } while (0)
#define PG8_LDA(dst, b, h) do { _Pragma("unroll") for (int m = 0; m < 4; ++m) _Pragma("unroll") for (int k = 0; k < 2; ++k) dst[m][k] = *(const PG8_LAS bf16x8*)(lds + PG8_SA(b, h) + aoff + m * 2048 + k * 1024); } while (0)
#define PG8_LDB(dst, b, h) do { _Pragma("unroll") for (int n = 0; n < 2; ++n) _Pragma("unroll") for (int k = 0; k < 2; ++k) dst[n][k] = *(const PG8_LAS bf16x8*)(lds + PG8_SB(b, h) + boff + n * 2048 + k * 1024); } while (0)
#define PG8_MMA(ai, bj, At, Bt) do { __builtin_amdgcn_s_setprio(1); _Pragma("unroll") for (int m = 0; m < 4; ++m) _Pragma("unroll") for (int n = 0; n < 2; ++n) _Pragma("unroll") for (int k = 0; k < 2; ++k) \
        acc[ai][bj][m][n] = __builtin_amdgcn_mfma_f32_16x16x32_bf16(Bt[n][k], At[m][k], acc[ai][bj][m][n], 0, 0, 0); __builtin_amdgcn_s_setprio(0); } while (0)
#define PG8_WAIT_V(n) asm volatile("s_waitcnt vmcnt(" #n ")" ::: "memory")
#define PG8_WAIT_L(n) asm volatile("s_waitcnt lgkmcnt(" #n ")" ::: "memory")
#define PG8_BAR __builtin_amdgcn_s_barrier()
#define PG8_SCHED __builtin_amdgcn_sched_barrier(0)
    Unit cur, nxt; int ui = 0;
    if (!S.next(0, cur)) return;
    f32x4 acc[2][2][4][2];
#pragma unroll
    for (int a = 0; a < 2; ++a)
#pragma unroll
        for (int b = 0; b < 2; ++b)
#pragma unroll
            for (int m = 0; m < 4; ++m)
#pragma unroll
                for (int n = 0; n < 2; ++n) acc[a][b][m][n] = (f32x4){0.f, 0.f, 0.f, 0.f};
    bf16x8 At[4][2], B0[2][2], B1[2][2];
    const char* cA = (const char*)g.A + (size_t)cur.pm * tstep; const char* cB = (const char*)g.Bt + (size_t)cur.pn * tstep;
    S.a_ready(cur);
    if constexpr (SP2) {
        PG8_STAGE(PG8_SB(0, 0), cB, voffB); PG8_STAGE(PG8_SB(0, 1), cB + hstep, voffB); PG8_STAGE(PG8_SA(0, 0), cA, voffA); PG8_STAGE(PG8_SA(0, 1), cA + hstep, voffA);
        if (wr == 1) PG8_BAR;
        PG8_WAIT_V(2); PG8_BAR;
        PG8_STAGE(PG8_SB(1, 0), cB + kstep, voffB); PG8_STAGE(PG8_SA(1, 0), cA + kstep, voffA); PG8_STAGE(PG8_SB(1, 1), cB + hstep + kstep, voffB);
        PG8_WAIT_V(6); PG8_BAR;
    } else {
        PG8_STAGE(PG8_SB(0, 0), cB, voffB); PG8_STAGE(PG8_SA(0, 0), cA, voffA); PG8_STAGE(PG8_SB(0, 1), cB + hstep, voffB); PG8_STAGE(PG8_SA(0, 1), cA + hstep, voffA);
        if (wr == 1) PG8_BAR;
        PG8_WAIT_V(4); PG8_BAR;
        PG8_STAGE(PG8_SB(1, 0), cB + kstep, voffB); PG8_STAGE(PG8_SA(1, 0), cA + kstep, voffA); PG8_STAGE(PG8_SB(1, 1), cB + hstep + kstep, voffB);
        PG8_WAIT_V(6); PG8_BAR;
    }
    for (;;) {
        const bool has_next = S.next(ui + 1, nxt);
        const char* nA = has_next ? (const char*)g.A + (size_t)nxt.pm * tstep : cA; const char* nB = has_next ? (const char*)g.Bt + (size_t)nxt.pn * tstep : cB;
        for (int t = 0; t < nt; t += 2) {
            const bool last = (t == nt - 2);
            const char* a1 = cA + (size_t)(t + 1) * kstep;
            const char* a2 = last ? nA : cA + (size_t)(t + 2) * kstep; const char* b2 = last ? nB : cB + (size_t)(t + 2) * kstep;
            const char* a3 = a2 + kstep; const char* b3 = b2 + kstep;
            if (last && has_next) S.a_ready(nxt);
            if constexpr (SP2) {
            PG8_LDB(B0, 0, 0); PG8_LDB(B1, 0, 1); PG8_SCHED; PG8_LDA(At, 0, 0); PG8_STAGE(PG8_SA(1, 1), a1 + hstep, voffA);
            PG8_WAIT_V(8); PG8_WAIT_L(0); PG8_BAR; PG8_MMA(0, 0, At, B0); PG8_MMA(0, 1, At, B1); PG8_BAR; PG8_SCHED;
            PG8_LDA(At, 0, 1); PG8_STAGE(PG8_SB(0, 0), b2, voffB); PG8_STAGE(PG8_SB(0, 1), b2 + hstep, voffB); PG8_STAGE(PG8_SA(0, 0), a2, voffA);
            PG8_WAIT_V(8); PG8_WAIT_L(0); PG8_BAR; PG8_MMA(1, 0, At, B0); PG8_MMA(1, 1, At, B1); PG8_BAR; PG8_SCHED;
            PG8_LDB(B0, 1, 0); PG8_LDB(B1, 1, 1); PG8_SCHED; PG8_LDA(At, 1, 0); PG8_STAGE(PG8_SA(0, 1), a2 + hstep, voffA);
            PG8_WAIT_V(8); PG8_WAIT_L(0); PG8_BAR; PG8_MMA(0, 0, At, B0); PG8_MMA(0, 1, At, B1); PG8_BAR; PG8_SCHED;
            PG8_LDA(At, 1, 1); PG8_STAGE(PG8_SB(1, 0), b3, voffB); PG8_STAGE(PG8_SB(1, 1), b3 + hstep, voffB); PG8_STAGE(PG8_SA(1, 0), a3, voffA);
            PG8_WAIT_V(8); PG8_WAIT_L(0); PG8_BAR; PG8_MMA(1, 0, At, B0); PG8_MMA(1, 1, At, B1); PG8_BAR; PG8_SCHED;
            } else {
            PG8_LDB(B0, 0, 0); PG8_SCHED; PG8_LDA(At, 0, 0); PG8_STAGE(PG8_SA(1, 1), a1 + hstep, voffA);
            PG8_WAIT_L(8); PG8_BAR; PG8_WAIT_L(0); PG8_MMA(0, 0, At, B0); PG8_BAR; PG8_SCHED;
            PG8_LDB(B1, 0, 1); PG8_STAGE(PG8_SB(0, 0), b2, voffB);
            PG8_BAR; PG8_WAIT_L(0); PG8_MMA(0, 1, At, B1); PG8_BAR;
            PG8_LDA(At, 0, 1); PG8_STAGE(PG8_SA(0, 0), a2, voffA);
            PG8_BAR; PG8_WAIT_L(0); PG8_MMA(1, 0, At, B0); PG8_BAR; PG8_SCHED;
            PG8_STAGE(PG8_SB(0, 1), b2 + hstep, voffB);
            PG8_WAIT_V(6); PG8_BAR; PG8_MMA(1, 1, At, B1); PG8_BAR;
            PG8_LDB(B0, 1, 0); PG8_SCHED; PG8_LDA(At, 1, 0); PG8_STAGE(PG8_SA(0, 1), a2 + hstep, voffA);
            PG8_WAIT_L(8); PG8_BAR; PG8_WAIT_L(0); PG8_MMA(0, 0, At, B0); PG8_BAR; PG8_SCHED;
            PG8_LDB(B1, 1, 1); PG8_STAGE(PG8_SB(1, 0), b3, voffB);
            PG8_BAR; PG8_WAIT_L(0); PG8_MMA(0, 1, At, B1); PG8_BAR;
            PG8_LDA(At, 1, 1); PG8_STAGE(PG8_SA(1, 0), a3, voffA);
            PG8_BAR; PG8_WAIT_L(0); PG8_MMA(1, 0, At, B0); PG8_BAR; PG8_SCHED;
            PG8_STAGE(PG8_SB(1, 1), b3 + hstep, voffB);
            PG8_WAIT_V(6); PG8_BAR; PG8_MMA(1, 1, At, B1); PG8_BAR;
            }
        }
        if constexpr (ALIGN_EPI) { if (wr == 0) PG8_BAR; }
        if constexpr (!Epi::AFTER_DRAIN) { E(acc, cur, wr, wc, fr, fq); S.done(cur); }
        if (!has_next) break;
#pragma unroll
        for (int a = 0; a < 2; ++a)
#pragma unroll
            for (int b = 0; b < 2; ++b)
#pragma unroll
                for (int m = 0; m < 4; ++m)
#pragma unroll
                    for (int n = 0; n < 2; ++n) acc[a][b][m][n] = (f32x4){0.f, 0.f, 0.f, 0.f};
        cur = nxt; cA = nA; cB = nB; ++ui;
        if constexpr (ALIGN_EPI) { if (wr == 1) PG8_BAR; }
    }
    PG8_WAIT_V(0);
    if constexpr (!ALIGN_EPI) { if (wr == 0) PG8_BAR; }
    PG8_BAR;
    if constexpr (Epi::AFTER_DRAIN) { E.fused(acc, cur, wr, wc, fr, fq, lds, wid, lane); S.done(cur); }
#undef PG8_SA
#undef PG8_SB
#undef PG8_STAGE
#undef PG8_LDA
#undef PG8_LDB
#undef PG8_MMA
#undef PG8_WAIT_V
#undef PG8_WAIT_L
#undef PG8_BAR
#undef PG8_SCHED
}
}

#define LAS __attribute__((address_space(3)))
typedef unsigned short bf16_t;
typedef short bf16x8 __attribute__((ext_vector_type(8)));
typedef short s16x4 __attribute__((ext_vector_type(4)));
typedef float f32x4 __attribute__((ext_vector_type(4)));
typedef unsigned u32x4 __attribute__((ext_vector_type(4)));
typedef unsigned u32x2 __attribute__((ext_vector_type(2)));

constexpr int SEQ = 8192, NBATCH = 2, MTOK = NBATCH * SEQ, DM = 2048, DFF = 5632, DEPTH = 4;
constexpr int SWA_N = 2560, NSA_N = 3680, NSA_LD = 3840, GU_N = 2 * DFF;
constexpr int NCMP = 511, CMP_ROWS = 4096;
constexpr float RMS_EPS = 1e-6f, LOG2E = 1.4426950408889634f, QSC = 0.125f * 1.4426950408889634f;
constexpr size_t MiB = 1u << 20;
constexpr size_t WS_WIN = 0, WS_WO = 16 * MiB, WS_WGU = 24 * MiB, WS_WDN = 68 * MiB, WS_WC1 = 90 * MiB, WS_H = 96 * MiB;
constexpr size_t WS_PROJ = 160 * MiB, WS_O = 280 * MiB, WS_MIX = 344 * MiB, WS_ACMP = 472 * MiB, WS_HID = 504 * MiB, WS_KVC = 512 * MiB;
constexpr size_t WS_CTL = 94 * MiB, CTL_BYTES = 16384;
constexpr size_t WS_GU = 160 * MiB, WS_ACT = 520 * MiB, WS_END = 696 * MiB;
constexpr int ROWE = 80;
constexpr int KS_OFF = 0, KS_BYTES = 64 * ROWE * 2, VT_OFF = 2 * KS_BYTES, VT_BYTES = 64 * ROWE * 2, IMP_OFF = 2 * KS_BYTES + 2 * VT_BYTES, SELM_OFF = IMP_OFF + 16384, UNI_OFF = SELM_OFF + 1024, OACC_OFF = UNI_OFF + 1024;
static_assert(OACC_OFF + 65536 <= 131072, "attention LDS map");
constexpr int LDS_BYTES = 131072 + 1024;

struct Args { const float* in[19]; float* out; unsigned char* ws; int ph_lo, ph_hi, coop, pad; };

__device__ __forceinline__ float bf2f(unsigned short v) { return __uint_as_float(((unsigned)v) << 16); }
__device__ __forceinline__ float bflo(unsigned v) { return __uint_as_float(v << 16); }
__device__ __forceinline__ float bfhi(unsigned v) { return __uint_as_float(v & 0xffff0000u); }
typedef float f32x2_t __attribute__((ext_vector_type(2))); typedef __bf16 bf16x2_t __attribute__((ext_vector_type(2)));
__device__ __forceinline__ unsigned pk2(float lo, float hi) { f32x2_t v = {lo, hi}; bf16x2_t b = __builtin_convertvector(v, bf16x2_t); return __builtin_bit_cast(unsigned, b); }
__device__ __forceinline__ float wave_sum(float v) {
#pragma unroll
    for (int o = 1; o < 64; o <<= 1) v += __shfl_xor(v, o);
    return v;
}


#define GAS __attribute__((address_space(1)))
typedef GAS unsigned gu32;
#define XB_TMO      128
#define XB_XCNT(j)  (256  + 64 * (j))
#define XB_XSUB(j)  (1280 + 64 * (j))
#define XB_XGEN(j)  (2304 + 64 * (j))
#define XB_TOP      3328
#define XB_TOPGEN   3392
#define XCD_BAR_WORDS 3456
#define XB_SPIN_CAP (1u << 18)

__device__ __forceinline__ unsigned xb_ld(unsigned* p)              { return __hip_atomic_load(p, __ATOMIC_RELAXED, __HIP_MEMORY_SCOPE_AGENT); }
__device__ __forceinline__ unsigned xb_add(unsigned* p, unsigned v) { return __hip_atomic_fetch_add(p, v, __ATOMIC_RELAXED, __HIP_MEMORY_SCOPE_AGENT); }
__device__ __forceinline__ unsigned xb_xcc_id() { return (unsigned)__builtin_amdgcn_s_getreg((3 << 11) | 20) & 0xFu; }
#define XB_SPIN(cond, bar) do { unsigned _sp = 0; while (cond) { __builtin_amdgcn_s_sleep(1); \
    if ((++_sp & 255u) == 0u) { if (xb_ld(&(bar)[XB_TMO])) break; if (_sp > XB_SPIN_CAP) { atomicAdd(&(bar)[XB_TMO], 1u); break; } } } } while (0)

struct XcdBarrier {
    unsigned* bar; unsigned x;
    volatile LAS unsigned* st;
};

__device__ __forceinline__ XcdBarrier xcd_barrier_post(unsigned* bar, volatile LAS unsigned* st) {
    XcdBarrier b; b.bar = bar; b.x = xb_xcc_id(); b.st = st;
    if (threadIdx.x == 0) (void)xb_add(&bar[XB_XCNT(b.x)], 1u);
    return b;
}
__device__ __forceinline__ void xcd_barrier_complete(unsigned* bar, unsigned x, unsigned& nloc, unsigned& nx) {
    const unsigned G = gridDim.x * gridDim.y * gridDim.z;
    unsigned sum, cnt, mine, sp = 0u;
    for (;;) {
        sum = 0u; cnt = 0u; mine = 0u;
#pragma unroll
        for (unsigned j = 0; j < 16; ++j) { const unsigned c = xb_ld(&bar[XB_XCNT(j)]); sum += c; cnt += (c > 0u) ? 1u : 0u; mine = (j == x) ? c : mine; }
        if (sum == G) break;
        __builtin_amdgcn_s_sleep(1);
        if ((++sp & 255u) == 0u) { if (xb_ld(&bar[XB_TMO])) break; if (sp > XB_SPIN_CAP) { atomicAdd(&bar[XB_TMO], 1u); break; } }
    }
    nloc = mine > 0u ? mine : 1u; nx = cnt > 0u ? cnt : 1u;
}

__device__ __forceinline__ void xcd_barrier(const XcdBarrier& b) {
    asm volatile("s_waitcnt vmcnt(0)" ::: "memory");
    __syncthreads();
    if (threadIdx.x == 0) {
        unsigned* bar = b.bar;
        __builtin_amdgcn_s_waitcnt(0);
        unsigned nloc = b.st[0], nx = b.st[1];
        if (nloc == 0u) { xcd_barrier_complete(bar, b.x, nloc, nx); b.st[0] = nloc; b.st[1] = nx; }
        const unsigned old = xb_add(&bar[XB_XSUB(b.x)], 1u);
        const unsigned gen = old / nloc;
        if (old + 1u == (gen + 1u) * nloc) {
            __builtin_amdgcn_fence(__ATOMIC_RELEASE, "agent");
            asm volatile("s_waitcnt vmcnt(0)" ::: "memory");
            const unsigned og = xb_add(&bar[XB_TOP], 1u);
            const unsigned tg = og / nx;
            if (og + 1u == (tg + 1u) * nx) xb_add(&bar[XB_TOPGEN], 1u);
            else XB_SPIN(xb_ld(&bar[XB_TOPGEN]) == tg, bar);
            __builtin_amdgcn_fence(__ATOMIC_ACQUIRE, "agent");
            xb_add(&bar[XB_XGEN(b.x)], 1u);
            asm volatile("s_waitcnt vmcnt(0)" ::: "memory");
        } else {
            XB_SPIN(xb_ld(&bar[XB_XGEN(b.x)]) == gen, bar);
            __builtin_amdgcn_fence(__ATOMIC_ACQUIRE, "agent");
            asm volatile("s_waitcnt vmcnt(0)" ::: "memory");
        }
    }
    __syncthreads();
}

__device__ __forceinline__ void transpose_item(const float* W, int K, int N, bf16_t* WT, int ilv, int add, LAS float* scr, int item, int lane) {
    const int nblk = N / 32, kb = item / nblk, nb = item % nblk, k0 = 64 * kb, n0 = 32 * nb;
#pragma unroll
    for (int i = 0; i < 8; ++i) { const int kk = 8 * i + (lane >> 3), n4 = (lane & 7) * 4; const f32x4 v = __builtin_nontemporal_load((const f32x4*)(W + (size_t)(k0 + kk) * N + n0 + n4));
        LAS float* d = scr + kk * 33 + n4; d[0] = v.x; d[1] = v.y; d[2] = v.z; d[3] = v.w; }
    asm volatile("s_waitcnt lgkmcnt(0)" ::: "memory");
    const int c = lane & 7;
#pragma unroll
    for (int j = 0; j < 4; ++j) { const int nl = (lane >> 3) + 8 * j; const LAS float* s = scr + (8 * c) * 33 + nl;
        u32x4 o; o.x = pk2(s[0 * 33], s[1 * 33]); o.y = pk2(s[2 * 33], s[3 * 33]); o.z = pk2(s[4 * 33], s[5 * 33]); o.w = pk2(s[6 * 33], s[7 * 33]);
        const int n = n0 + nl; const int row = ilv ? (((n >> 7) << 8) + (n & 127) + add) : n;
        *(u32x4*)(WT + (size_t)row * K + k0 + 8 * c) = o; }
    asm volatile("s_waitcnt lgkmcnt(0)" ::: "memory");
}
__device__ __forceinline__ void convert_weights(const Args& a, int L, LAS unsigned char* lds, int gw, int NGW, int wave, int lane) {
    LAS float* scr = (LAS float*)(lds + wave * 16384);
    const int j = L >> 1; const bool nsa = (L & 1) != 0;
    const int NIN = nsa ? NSA_N : SWA_N;
    const float* w_in = nsa ? a.in[7] + (size_t)j * DM * NSA_N : a.in[2] + (size_t)j * DM * SWA_N;
    const float* w_o = nsa ? a.in[13] + (size_t)j * DM * DM : a.in[5] + (size_t)j * DM * DM;
    const float* w_g = a.in[14] + (size_t)L * DM * DFF; const float* w_u = a.in[15] + (size_t)L * DM * DFF; const float* w_d = a.in[18] + (size_t)L * DFF * DM;
    const float* w_c = a.in[9] + (size_t)j * 2 * DM * 512;
    bf16_t* WIN = (bf16_t*)(a.ws + WS_WIN); bf16_t* WO = (bf16_t*)(a.ws + WS_WO); bf16_t* WGU = (bf16_t*)(a.ws + WS_WGU); bf16_t* WDN = (bf16_t*)(a.ws + WS_WDN); bf16_t* WC1 = (bf16_t*)(a.ws + WS_WC1);
    const int I0 = 32 * (NIN / 32), I1 = 32 * 64, I2 = 32 * (DFF / 32), I4 = (DFF / 64) * 64, I5 = nsa ? 32 * 16 : 0;
    const int total = I0 + I1 + 2 * I2 + I4 + 2 * I5;
    for (int it = gw; it < total; it += NGW) {
        int r = it;
        if (r < I0) { transpose_item(w_in, DM, NIN, WIN, 0, 0, scr, r, lane); continue; } r -= I0;
        if (r < I1) { transpose_item(w_o, DM, DM, WO, 0, 0, scr, r, lane); continue; } r -= I1;
        if (r < I2) { transpose_item(w_g, DM, DFF, WGU, 1, 0, scr, r, lane); continue; } r -= I2;
        if (r < I2) { transpose_item(w_u, DM, DFF, WGU, 1, 128, scr, r, lane); continue; } r -= I2;
        if (r < I4) { transpose_item(w_d, DFF, DM, WDN, 0, 0, scr, r, lane); continue; } r -= I4;
        if (r < I5) { transpose_item(w_c, DM, 512, WC1, 0, 0, scr, r, lane); continue; } r -= I5;
        transpose_item(w_c + (size_t)DM * 512, DM, 512, WC1 + (size_t)512 * DM, 0, 0, scr, r, lane);
    }
}

__device__ __forceinline__ void row_phase(const bf16_t* mix, const float* xsrc, float* xdst, const float* gA, const float* gB, bf16_t* H, int gw, int NGW, int lane) {
    f32x4 ga[8], gb[8];
#pragma unroll
    for (int j = 0; j < 8; ++j) { ga[j] = mix ? ((const f32x4*)gA)[lane + 64 * j] : (f32x4){0.f, 0.f, 0.f, 0.f}; gb[j] = gB ? ((const f32x4*)gB)[lane + 64 * j] : (f32x4){0.f, 0.f, 0.f, 0.f}; }
    for (int row = gw; row < MTOK; row += NGW) {
        const f32x4* xr = (const f32x4*)(xsrc + (size_t)row * DM) + lane;
        f32x4 xv[8];
#pragma unroll
        for (int j = 0; j < 8; ++j) xv[j] = __builtin_nontemporal_load(&xr[64 * j]);
        if (mix) {
            const u32x2* mr = (const u32x2*)(mix + (size_t)row * DM) + lane;
            f32x4 mv[8]; float ss = 0.f;
#pragma unroll
            for (int j = 0; j < 8; ++j) { const u32x2 mb = __builtin_nontemporal_load(&mr[64 * j]); mv[j] = (f32x4){bflo(mb.x), bfhi(mb.x), bflo(mb.y), bfhi(mb.y)}; ss += (mv[j].x * mv[j].x + mv[j].y * mv[j].y) + (mv[j].z * mv[j].z + mv[j].w * mv[j].w); }
            const float r1 = 1.0f / sqrtf(wave_sum(ss) * (1.0f / DM) + RMS_EPS);
            f32x4* xo = (f32x4*)(xdst + (size_t)row * DM) + lane;
#pragma unroll
            for (int j = 0; j < 8; ++j) { const f32x4 g = ga[j]; xv[j] = xv[j] + mv[j] * r1 * g; __builtin_nontemporal_store(xv[j], &xo[64 * j]); }
        }
        if (gB) {
            float ss = 0.f;
#pragma unroll
            for (int j = 0; j < 8; ++j) ss += (xv[j].x * xv[j].x + xv[j].y * xv[j].y) + (xv[j].z * xv[j].z + xv[j].w * xv[j].w);
            const float r2 = 1.0f / sqrtf(wave_sum(ss) * (1.0f / DM) + RMS_EPS);
            u32x2* ho = (u32x2*)(H + (size_t)row * DM) + lane;
#pragma unroll
            for (int j = 0; j < 8; ++j) { const f32x4 g = gb[j]; const f32x4 h = xv[j] * r2 * g; u32x2 o; o.x = pk2(h.x, h.y); o.y = pk2(h.z, h.w); ho[64 * j] = o; }
        }
    }
}

__device__ __forceinline__ void act_phase(const bf16_t* GU, bf16_t* ACT, const float* cw, const float* cb, int gtid, int nthreads) {
    constexpr int NFC = DFF / 8, NRB = MTOK / 16;
    for (int it = gtid; it < NFC * NRB; it += nthreads) {
        const int fc = it % NFC, rb = it / NFC, f0 = fc * 8, r0 = rb * 16;
        const int gcol = ((f0 >> 7) << 8) + (f0 & 127);
        float w0[8], w1[8], w2[8], bb[8];
#pragma unroll
        for (int e = 0; e < 8; ++e) { w0[e] = cw[f0 + e]; w1[e] = cw[DFF + f0 + e]; w2[e] = cw[2 * DFF + f0 + e]; bb[e] = cb[f0 + e]; }
        float g2[8], g1[8];
        const bool has_prev = (r0 & (SEQ - 1)) != 0;
        {
            u32x4 a2 = (u32x4){0, 0, 0, 0}, a1 = (u32x4){0, 0, 0, 0};
            if (has_prev) { a2 = *(const u32x4*)(GU + (size_t)(r0 - 2) * GU_N + gcol); a1 = *(const u32x4*)(GU + (size_t)(r0 - 1) * GU_N + gcol); }
            g2[0] = bflo(a2.x); g2[1] = bfhi(a2.x); g2[2] = bflo(a2.y); g2[3] = bfhi(a2.y); g2[4] = bflo(a2.z); g2[5] = bfhi(a2.z); g2[6] = bflo(a2.w); g2[7] = bfhi(a2.w);
            g1[0] = bflo(a1.x); g1[1] = bfhi(a1.x); g1[2] = bflo(a1.y); g1[3] = bfhi(a1.y); g1[4] = bflo(a1.z); g1[5] = bfhi(a1.z); g1[6] = bflo(a1.w); g1[7] = bfhi(a1.w);
        }
#pragma unroll 4
        for (int i = 0; i < 16; ++i) {
            const u32x4 gv = *(const u32x4*)(GU + (size_t)(r0 + i) * GU_N + gcol);
            const u32x4 uv = *(const u32x4*)(GU + (size_t)(r0 + i) * GU_N + gcol + 128);
            float g0[8], up[8], o[8];
            g0[0] = bflo(gv.x); g0[1] = bfhi(gv.x); g0[2] = bflo(gv.y); g0[3] = bfhi(gv.y); g0[4] = bflo(gv.z); g0[5] = bfhi(gv.z); g0[6] = bflo(gv.w); g0[7] = bfhi(gv.w);
            up[0] = bflo(uv.x); up[1] = bfhi(uv.x); up[2] = bflo(uv.y); up[3] = bfhi(uv.y); up[4] = bflo(uv.z); up[5] = bfhi(uv.z); up[6] = bflo(uv.w); up[7] = bfhi(uv.w);
#pragma unroll
            for (int e = 0; e < 8; ++e) { const float av = bb[e] + w0[e] * g2[e] + w1[e] * g1[e] + w2[e] * g0[e];
                o[e] = av * __builtin_amdgcn_rcpf(1.0f + __builtin_amdgcn_exp2f(-LOG2E * av)) * up[e]; g2[e] = g1[e]; g1[e] = g0[e]; }
            u32x4 ov; ov.x = pk2(o[0], o[1]); ov.y = pk2(o[2], o[3]); ov.z = pk2(o[4], o[5]); ov.w = pk2(o[6], o[7]);
            *(u32x4*)(ACT + (size_t)(r0 + i) * DFF + f0) = ov;
        }
    }
}


__device__ __forceinline__ void act_fixup(const bf16_t* SBG0, const bf16_t* SBU0, const bf16_t* SBG1, bf16_t* ACT, const float* cw, const float* cb, int gtid, int nthreads) {
    constexpr int NFC = DFF / 8, NGRP = MTOK / 64;
    for (int it = gtid; it < NFC * NGRP * 2; it += nthreads) {
        const int fc = it % NFC, gr = it / NFC, r = gr & 1, grp = gr >> 1, f0 = fc * 8;
        const bool has_prev = (grp % (SEQ / 64)) != 0;
        const u32x4 z = (u32x4){0, 0, 0, 0};
        const u32x4 own0 = *(const u32x4*)(SBG0 + (size_t)(grp * 2 + 0) * DFF + f0), own1 = *(const u32x4*)(SBG0 + (size_t)(grp * 2 + 1) * DFF + f0);
        const u32x4 upv = *(const u32x4*)(SBU0 + (size_t)(grp * 2 + r) * DFF + f0);
        const u32x4 p62 = has_prev ? *(const u32x4*)(SBG1 + (size_t)((grp - 1) * 2 + 0) * DFF + f0) : z, p63 = has_prev ? *(const u32x4*)(SBG1 + (size_t)((grp - 1) * 2 + 1) * DFF + f0) : z;
        const u32x4 a2 = r ? p63 : p62, a1 = r ? own0 : p63, a0 = r ? own1 : own0;
        float g2[8], g1[8], g0[8], up[8], o[8];
        g2[0] = bflo(a2.x); g2[1] = bfhi(a2.x); g2[2] = bflo(a2.y); g2[3] = bfhi(a2.y); g2[4] = bflo(a2.z); g2[5] = bfhi(a2.z); g2[6] = bflo(a2.w); g2[7] = bfhi(a2.w);
        g1[0] = bflo(a1.x); g1[1] = bfhi(a1.x); g1[2] = bflo(a1.y); g1[3] = bfhi(a1.y); g1[4] = bflo(a1.z); g1[5] = bfhi(a1.z); g1[6] = bflo(a1.w); g1[7] = bfhi(a1.w);
        g0[0] = bflo(a0.x); g0[1] = bfhi(a0.x); g0[2] = bflo(a0.y); g0[3] = bfhi(a0.y); g0[4] = bflo(a0.z); g0[5] = bfhi(a0.z); g0[6] = bflo(a0.w); g0[7] = bfhi(a0.w);
        up[0] = bflo(upv.x); up[1] = bfhi(upv.x); up[2] = bflo(upv.y); up[3] = bfhi(upv.y); up[4] = bflo(upv.z); up[5] = bfhi(upv.z); up[6] = bflo(upv.w); up[7] = bfhi(upv.w);
#pragma unroll
        for (int e = 0; e < 8; ++e) { const float av = cb[f0 + e] + cw[f0 + e] * g2[e] + cw[DFF + f0 + e] * g1[e] + cw[2 * DFF + f0 + e] * g0[e];
            o[e] = av * __builtin_amdgcn_rcpf(1.0f + __builtin_amdgcn_exp2f(-LOG2E * av)) * up[e]; }
        u32x4 ov; ov.x = pk2(o[0], o[1]); ov.y = pk2(o[2], o[3]); ov.z = pk2(o[4], o[5]); ov.w = pk2(o[6], o[7]);
        *(u32x4*)(ACT + (size_t)(grp * 64 + r) * DFF + f0) = ov;
    }
}
__device__ __forceinline__ void cmp_build(const bf16_t* PROJ, const float* pe  , bf16_t* ACMP, int gtid, int nthreads) {
    for (int it = gtid; it < 2 * CMP_ROWS * 256; it += nthreads) {
        const int piece = it & 255, row = (it >> 8) & (CMP_ROWS - 1), kv = it >> 20;
        u32x4 o = (u32x4){0, 0, 0, 0};
        if (row < NBATCH * NCMP * 4) {
            const int g = row & 3, bn = row >> 2, n = bn % NCMP, b = bn / NCMP, l = piece >> 3, d0 = (piece & 7) * 8;
            const u32x4 s = *(const u32x4*)(PROJ + (size_t)(b * SEQ + 16 * n + l) * NSA_LD + 2048 + kv * 256 + g * 64 + d0);
            const float* p = pe + (kv * 32 + l) * 64 + d0;
            o.x = pk2(bflo(s.x) + p[0], bfhi(s.x) + p[1]); o.y = pk2(bflo(s.y) + p[2], bfhi(s.y) + p[3]);
            o.z = pk2(bflo(s.z) + p[4], bfhi(s.z) + p[5]); o.w = pk2(bflo(s.w) + p[6], bfhi(s.w) + p[7]);
        }
        *(u32x4*)(ACMP + ((size_t)kv * CMP_ROWS + row) * 2048 + piece * 8) = o;
    }
}
__device__ __forceinline__ void cmp_out(const bf16_t* HID, const float* w2  , const float* b2  , bf16_t* KVC, LAS unsigned char* lds, int tid, int gw, int NGW) {
    LAS float* wl = (LAS float*)lds;
    const int lane = tid & 63;
    for (int kv = 0; kv < 2; ++kv) {
        __syncthreads();
        for (int i = tid; i < 512 * 64 / 4; i += 512) ((LAS f32x4*)wl)[i] = ((const f32x4*)(w2 + (size_t)kv * 512 * 64))[i];
        __syncthreads();
        const float bias = b2[kv * 64 + lane];
        for (int r = gw; r < 2 * 4 * 512; r += NGW) {
            const int n = r & 511, g = (r >> 9) & 3, b = r >> 11;
            float acc = 0.f;
            if (n < NCMP) {
                const int row = (b * NCMP + n) * 4 + g;
                const u32x4* hp = (const u32x4*)(HID + ((size_t)kv * CMP_ROWS + row) * 512);
                float a0 = bias, a1 = 0.f, a2 = 0.f, a3 = 0.f;
#pragma unroll 4
                for (int c8 = 0; c8 < 64; ++c8) { const u32x4 h = hp[c8]; const LAS float* w = wl + c8 * 8 * 64 + lane;
                    a0 += bflo(h.x) * w[0] + bfhi(h.x) * w[64]; a1 += bflo(h.y) * w[128] + bfhi(h.y) * w[192]; a2 += bflo(h.z) * w[256] + bfhi(h.z) * w[320]; a3 += bflo(h.w) * w[384] + bfhi(h.w) * w[448]; }
                acc = (a0 + a1) + (a2 + a3);
            }
            KVC[((size_t)kv * 4096 + r) * 64 + lane] = (bf16_t)(pk2(acc, 0.f) & 0xffffu);
        }
    }
    __syncthreads();
}

constexpr float MFLOOR = -3.0e4f;

__device__ __forceinline__ float xmax16(float v) { auto r = __builtin_amdgcn_permlane16_swap(__float_as_uint(v), __float_as_uint(v), false, false); return fmaxf(__uint_as_float(r[0]), __uint_as_float(r[1])); }
__device__ __forceinline__ float xmax32(float v) { auto r = __builtin_amdgcn_permlane32_swap(__float_as_uint(v), __float_as_uint(v), false, false); return fmaxf(__uint_as_float(r[0]), __uint_as_float(r[1])); }
__device__ __forceinline__ float xsum16(float v) { auto r = __builtin_amdgcn_permlane16_swap(__float_as_uint(v), __float_as_uint(v), false, false); return __uint_as_float(r[0]) + __uint_as_float(r[1]); }
__device__ __forceinline__ float xsum32(float v) { auto r = __builtin_amdgcn_permlane32_swap(__float_as_uint(v), __float_as_uint(v), false, false); return __uint_as_float(r[0]) + __uint_as_float(r[1]); }
template <int CTRL> __device__ __forceinline__ float dppf(float v) { return __int_as_float(__builtin_amdgcn_update_dpp(0, __float_as_int(v), CTRL, 0xF, 0xF, true)); }
template <int CTRL> __device__ __forceinline__ int dppi(int v) { return __builtin_amdgcn_update_dpp(0, v, CTRL, 0xF, 0xF, true); }
constexpr int DPP_X1 = 0xB1  , DPP_X2 = 0x4E  , DPP_HM = 0x141  , DPP_RM = 0x140  ;
constexpr int NQT = 2, UQ = 16 * NQT, NUNIT = MTOK * 4 / UQ, QBN = SEQ / UQ;
template <int MODE, int KSTRIDE, bool MASKED = true, bool SEL = false>
__device__ __forceinline__ void chunk_compute(LAS const unsigned char* Ks, LAS const unsigned char* Vt, const bf16x8 (&qf)[NQT][2], float (&m)[NQT], float (&l)[NQT], f32x4 (&O)[NQT][4], f32x4 (&L)[NQT], const bf16x8 onesf,
                                              int tq0, float sl2, int kp0, int W, unsigned selbits, int c, int quad,
                                              volatile LAS float* imp_rows, int jb0, const float (&linv)[NQT]) {
    int dbase = tq0 - kp0 - quad * 4 * KSTRIDE;
    asm volatile("" : "+v"(dbase));
    bf16x8 kf[4][2];
#pragma unroll
    for (int kt = 0; kt < 4; ++kt)
#pragma unroll
        for (int ks = 0; ks < 2; ++ks) kf[kt][ks] = *(LAS const bf16x8*)(Ks + ((kt * 16 + c) * ROWE + ks * 32 + quad * 8) * 2);
    bf16x8 pb[NQT][2]; bool act[NQT];
#pragma unroll
    for (int qt = 0; qt < NQT; ++qt) {
        const bool selq = ((selbits >> qt) & 1u) != 0u;
        act[qt] = SEL ? (__any(selq ? 1 : 0) != 0) : true;
        pb[qt][0] = (bf16x8){0, 0, 0, 0, 0, 0, 0, 0}; pb[qt][1] = pb[qt][0];
        if (!act[qt]) continue;
        f32x4 s[4];
        const int dq = dbase + 2 * qt; const float bbq = (MASKED || selq) ? -sl2 * (float)dq : -1e30f;
#pragma unroll
        for (int kt = 0; kt < 4; ++kt) {
            s[kt] = (f32x4){__builtin_fmaf(sl2, (float)((kt * 16 + 0) * KSTRIDE), bbq), __builtin_fmaf(sl2, (float)((kt * 16 + 1) * KSTRIDE), bbq), __builtin_fmaf(sl2, (float)((kt * 16 + 2) * KSTRIDE), bbq), __builtin_fmaf(sl2, (float)((kt * 16 + 3) * KSTRIDE), bbq)};
#pragma unroll
            for (int ks = 0; ks < 2; ++ks) s[kt] = __builtin_amdgcn_mfma_f32_16x16x32_bf16(kf[kt][ks], qf[qt][ks], s[kt], 0, 0, 0);
        }
        float mx = -1e30f;
        const int tqq = tq0 + 2 * qt;
        const unsigned lim = selq ? (unsigned)(W < tqq + 1 ? W : tqq + 1) : 0u;
#pragma unroll
        for (int kt = 0; kt < 4; ++kt)
#pragma unroll
            for (int j = 0; j < 4; ++j) {
                const int C = (kt * 16 + j) * KSTRIDE;
                float v = s[kt][j];
                if (MASKED) { const bool valid = (unsigned)(dq - C) < lim; v = valid ? v : -1e30f; }
                s[kt][j] = v; mx = fmaxf(mx, v);
            }
        if (MODE != 2) {
            mx = xmax32(xmax16(mx));
            const float mnew = fmaxf(m[qt], mx); const float alpha = __builtin_amdgcn_exp2f(m[qt] - mnew); m[qt] = mnew;
            float psum = 0.f;
#pragma unroll
            for (int kt = 0; kt < 4; ++kt)
#pragma unroll
                for (int j = 0; j < 4; ++j) { const float p = __builtin_amdgcn_exp2f(s[kt][j] - mnew); s[kt][j] = p; psum += p; }
            if (MODE == 1) l[qt] = l[qt] * alpha + psum;
            if (MODE == 0) {
                L[qt] = L[qt] * alpha;
#pragma unroll
                for (int dt = 0; dt < 4; ++dt) O[qt][dt] = O[qt][dt] * alpha;
            }
        } else {
#pragma unroll
            for (int kt = 0; kt < 4; ++kt)
#pragma unroll
                for (int j = 0; j < 4; ++j) { const float p = __builtin_amdgcn_exp2f(s[kt][j] - m[qt]) * linv[qt]; s[kt][j] = p; }
#pragma unroll
            for (int kt = 0; kt < 4; ++kt) {
                f32x4 hs = s[kt];
#pragma unroll
                for (int j = 0; j < 4; ++j) { hs[j] += dppf<DPP_X1>(hs[j]); hs[j] += dppf<DPP_X2>(hs[j]); hs[j] += dppf<DPP_HM>(hs[j]); }
                if ((c & 7) == 0) {
                    const int ql = qt * 2 + (c >> 3); const int jb = jb0 + kt * 4 + quad;
                    LAS float* p0 = (LAS float*)imp_rows + ql * 128 + jb;
                    (void)__hip_atomic_fetch_add(p0, (hs[0] + hs[1]) + (hs[2] + hs[3]), __ATOMIC_RELAXED, __HIP_MEMORY_SCOPE_WORKGROUP);
                    if (jb + 1 < 128) (void)__hip_atomic_fetch_add(p0 + 1, hs[3], __ATOMIC_RELAXED, __HIP_MEMORY_SCOPE_WORKGROUP);
                }
            }
        }
        if (MODE != 1) {
#pragma unroll
            for (int i = 0; i < 2; ++i) {
                u32x4 w; w.x = pk2(s[2 * i][0], s[2 * i][1]); w.y = pk2(s[2 * i][2], s[2 * i][3]); w.z = pk2(s[2 * i + 1][0], s[2 * i + 1][1]); w.w = pk2(s[2 * i + 1][2], s[2 * i + 1][3]);
                pb[qt][i] = __builtin_bit_cast(bf16x8, w);
            }
        }
    }
    if (MODE != 1) {
        bf16x8 vf[4][2];
#pragma unroll
        for (int dt = 0; dt < 4; ++dt)
#pragma unroll
            for (int i = 0; i < 2; ++i) {
                vf[dt][i] = *(LAS const bf16x8*)(Vt + ((dt * 16 + c) * ROWE + ((32 * i + quad * 8) ^ (dt * 16))) * 2);
            }
#pragma unroll
        for (int qt = 0; qt < NQT; ++qt) {
            if (!act[qt]) continue;
#pragma unroll
            for (int dt = 0; dt < 4; ++dt)
#pragma unroll
                for (int i = 0; i < 2; ++i) O[qt][dt] = __builtin_amdgcn_mfma_f32_16x16x32_bf16(vf[dt][i], pb[qt][i], O[qt][dt], 0, 0, 0);
            if (MODE == 0) {
#pragma unroll
                for (int i = 0; i < 2; ++i) L[qt] = __builtin_amdgcn_mfma_f32_16x16x32_bf16(onesf, pb[qt][i], L[qt], 0, 0, 0);
            }
        }
    }
}

__device__ __forceinline__ bf16x8 scale_q(bf16x8 q) {
    const u32x4 u = __builtin_bit_cast(u32x4, q); u32x4 o;
    o.x = pk2(bflo(u.x) * QSC, bfhi(u.x) * QSC); o.y = pk2(bflo(u.y) * QSC, bfhi(u.y) * QSC); o.z = pk2(bflo(u.z) * QSC, bfhi(u.z) * QSC); o.w = pk2(bflo(u.w) * QSC, bfhi(u.w) * QSC);
    return __builtin_bit_cast(bf16x8, o);
}
#define STG_LOAD(kp_, vp_, ld_, row_) do { const int rr_ = (row_) + (tid >> 3); if (rr_ >= 0 && rr_ < SEQ) { kreg = *(const u32x4*)((kp_) + (size_t)rr_ * (ld_) + (tid & 7) * 8); vreg = *(const u32x4*)((vp_) + (size_t)rr_ * (ld_) + (tid & 7) * 8); } \
        else { kreg = (u32x4){0, 0, 0, 0}; vreg = (u32x4){0, 0, 0, 0}; } } while (0)
#define STG_STORE(buf_) do { *(LAS u32x4*)(lds + KS_OFF + (buf_) * KS_BYTES + (tid >> 3) * (ROWE * 2) + (tid & 7) * 16) = kreg; \
        const int key_ = tid >> 3, pos_ = ((key_ & ~31) + ((key_ >> 2) & 3) * 8 + ((key_ >> 4) & 1) * 4 + (key_ & 3)) ^ (((tid & 7) >> 1) << 4);         \
        LAS bf16_t* vt_ = (LAS bf16_t*)(lds + VT_OFF + (buf_) * VT_BYTES) + ((tid & 7) * 8) * ROWE + pos_; \
        vt_[0 * ROWE] = (bf16_t)(vreg.x & 0xffffu); vt_[1 * ROWE] = (bf16_t)(vreg.x >> 16); vt_[2 * ROWE] = (bf16_t)(vreg.y & 0xffffu); vt_[3 * ROWE] = (bf16_t)(vreg.y >> 16); \
        vt_[4 * ROWE] = (bf16_t)(vreg.z & 0xffffu); vt_[5 * ROWE] = (bf16_t)(vreg.z >> 16); vt_[6 * ROWE] = (bf16_t)(vreg.w & 0xffffu); vt_[7 * ROWE] = (bf16_t)(vreg.w >> 16); } while (0)
#define KSBUF(b_) ((LAS const unsigned char*)(lds + KS_OFF + (b_) * KS_BYTES))
#define VTBUF(b_) ((LAS const unsigned char*)(lds + VT_OFF + (b_) * VT_BYTES))

__device__ __forceinline__ void swa_unit(const bf16_t* PROJ, const float* sinks, bf16_t* Obuf, int unit, LAS unsigned char* lds, const int tid) {
    const int lane = tid & 63, w = tid >> 6, c = lane & 15, quad = lane >> 4;
    const int qb = unit % QBN, kvh = (unit / QBN) & 3, b = unit / (4 * QBN), t0 = qb * UQ;
    const int head = kvh * 8 + (c & 7);
    const float sl2 = __builtin_amdgcn_exp2f(-0.25f * (float)(head + 1)) * LOG2E;
    const bf16_t* base = PROJ + (size_t)b * SEQ * SWA_N;
    const bf16_t* kp = base + 2048 + kvh * 64; const bf16_t* vp = base + 2304 + kvh * 64;
    bf16x8 qf[NQT][2]; float m[NQT], l[NQT], linv[NQT]; f32x4 O[NQT][4]; f32x4 L[NQT];
    const bf16x8 onesf = (c == 0) ? (bf16x8){0x3F80, 0x3F80, 0x3F80, 0x3F80, 0x3F80, 0x3F80, 0x3F80, 0x3F80} : (bf16x8){0, 0, 0, 0, 0, 0, 0, 0};
    const int tq0 = t0 + 2 * NQT * w + (c >> 3);
    const float sink2 = sinks[head] * LOG2E;
#pragma unroll
    for (int qt = 0; qt < NQT; ++qt) {
        m[qt] = sink2; l[qt] = 0.f; linv[qt] = 0.f; L[qt] = (f32x4){(quad == 0) ? 1.0f : 0.0f, 0.f, 0.f, 0.f};
#pragma unroll
        for (int ks = 0; ks < 2; ++ks) qf[qt][ks] = scale_q(__builtin_nontemporal_load((const bf16x8*)(base + (size_t)(tq0 + 2 * qt) * SWA_N + head * 64 + ks * 32 + quad * 8)));
#pragma unroll
        for (int dt = 0; dt < 4; ++dt) O[qt][dt] = (f32x4){0.f, 0.f, 0.f, 0.f};
    }
    u32x4 kreg, vreg;
    STG_LOAD(kp, vp, SWA_N, t0 - 128); STG_STORE(0); __syncthreads();
    for (int ci = 0; ci < 3; ++ci) {
        if (ci + 1 < 3) STG_LOAD(kp, vp, SWA_N, t0 - 128 + 64 * (ci + 1));
        chunk_compute<0, 1>(KSBUF(ci & 1), VTBUF(ci & 1), qf, m, l, O, L, onesf, tq0, sl2, t0 - 128 + 64 * ci, 128, 0xFu, c, quad, nullptr, 0, linv);
        if (ci + 1 < 3) STG_STORE((ci + 1) & 1);
        __syncthreads();
    }
#pragma unroll
    for (int qt = 0; qt < NQT; ++qt) {
        float lt = L[qt][0]; lt = xsum32(xsum16(lt));
        const float inv = 1.0f / lt;
        bf16_t* orow = Obuf + (size_t)(b * SEQ + (tq0 + 2 * qt)) * DM + head * 64 + quad * 4;
#pragma unroll
        for (int dt = 0; dt < 4; ++dt) { const f32x4 o = O[qt][dt] * inv; u32x2 pk; pk.x = pk2(o[0], o[1]); pk.y = pk2(o[2], o[3]); *(u32x2*)(orow + dt * 16) = pk; }
    }
}

#define GATE(qt_, i_) __builtin_amdgcn_rcpf(1.0f + __builtin_amdgcn_exp2f(-LOG2E * gatev[qt_][i_]))
__device__ __forceinline__ void nsa_unit(const bf16_t* PROJ, const bf16_t* KVC, float* OACC, bf16_t* Obuf, int unit, LAS unsigned char* lds, const int tid) {
    const int lane = tid & 63, w = tid >> 6, c = lane & 15, quad = lane >> 4;
    const int qb = unit % QBN, g = (unit / QBN) & 3, b = unit / (4 * QBN), t0 = qb * UQ;
    const int head = g * 8 + (c & 7);
    const float sl2 = __builtin_amdgcn_exp2f(-0.25f * (float)(head + 1)) * LOG2E;
    const bf16_t* base = PROJ + (size_t)b * SEQ * NSA_LD;
    volatile LAS float* imp_rows = (volatile LAS float*)(lds + IMP_OFF) + (2 * NQT * w) * 128;
    volatile LAS unsigned* selm = (volatile LAS unsigned*)(lds + SELM_OFF);
    volatile LAS unsigned* uni = (volatile LAS unsigned*)(lds + UNI_OFF);
    bf16x8 qf[NQT][2]; float m[NQT], l[NQT], linv[NQT]; f32x4 O[NQT][4]; f32x4 L[NQT];
    const bf16x8 onesf = (c == 0) ? (bf16x8){0x3F80, 0x3F80, 0x3F80, 0x3F80, 0x3F80, 0x3F80, 0x3F80, 0x3F80} : (bf16x8){0, 0, 0, 0, 0, 0, 0, 0};
    const int tq0 = t0 + 2 * NQT * w + (c >> 3);
#pragma unroll
    for (int qt = 0; qt < NQT; ++qt) {
        const bf16_t* prow = base + (size_t)(tq0 + 2 * qt) * NSA_LD;
#pragma unroll
        for (int ks = 0; ks < 2; ++ks) qf[qt][ks] = scale_q(__builtin_nontemporal_load((const bf16x8*)(prow + head * 64 + ks * 32 + quad * 8)));
    }
    for (int i = lane; i < 2 * NQT * 128; i += 64) imp_rows[i] = 0.f;
    float gatev[NQT][3];
#pragma unroll
    for (int qt = 0; qt < NQT; ++qt)
#pragma unroll
        for (int i = 0; i < 3; ++i) gatev[qt][i] = bf2f(base[(size_t)(tq0 + 2 * qt) * NSA_LD + 3584 + head * 3 + i]);
    u32x4 kreg, vreg;
    const bf16_t* kc = KVC + ((size_t)((0 * 2 + b) * 4 + g) * 512) * 64; const bf16_t* vc = KVC + ((size_t)((1 * 2 + b) * 4 + g) * 512) * 64;
    const int nmax = (t0 + UQ - 1 - 31) >> 4, ncc = (nmax >> 6) + 1;
    const bf16_t* ksl = base + 2560 + g * 64; const bf16_t* vsl = base + 2816 + g * 64;
    const bf16_t* kwp = base + 3072 + g * 64; const bf16_t* vwp = base + 3328 + g * 64;
    const int c0 = (t0 >= 512) ? 0 : (512 - t0) / 64;
#pragma unroll
    for (int qt = 0; qt < NQT; ++qt) { m[qt] = MFLOOR; l[qt] = 0.f; linv[qt] = 0.f; L[qt] = (f32x4){0.f, 0.f, 0.f, 0.f}; }
    STG_LOAD(kc, vc, 64, 0); STG_STORE(0); __syncthreads();
    {
        const int nun = (t0 >= 1039) ? (t0 - 1039) / 1024 + 1 : 0;
        int ci = 0;
        for (; ci < nun; ++ci) {
            STG_LOAD(kc, vc, 64, 64 * (ci + 1));
            chunk_compute<1, 16, false>(KSBUF(ci & 1), VTBUF(ci & 1), qf, m, l, O, L, onesf, tq0, sl2, 16 * (64 * ci) + 31, 1 << 30, 0xFu, c, quad, imp_rows, 0, linv);
            STG_STORE((ci + 1) & 1);
            __syncthreads();
        }
        for (; ci < ncc; ++ci) {
            STG_LOAD(kc, vc, 64, (ci + 1 < ncc) ? 64 * (ci + 1) : 0);
            chunk_compute<1, 16, true>(KSBUF(ci & 1), VTBUF(ci & 1), qf, m, l, O, L, onesf, tq0, sl2, 16 * (64 * ci) + 31, 1 << 30, 0xFu, c, quad, imp_rows, 0, linv);
            STG_STORE((ci + 1) & 1);
            __syncthreads();
        }
    }
#pragma unroll
    for (int qt = 0; qt < NQT; ++qt) {
        float lt = l[qt]; lt = xsum32(xsum16(lt)); linv[qt] = lt > 0.f ? 1.0f / lt : 0.f;
#pragma unroll
        for (int dt = 0; dt < 4; ++dt) O[qt][dt] = (f32x4){0.f, 0.f, 0.f, 0.f};
    }
    {
        const int nun = (t0 >= 1039) ? (t0 - 1039) / 1024 + 1 : 0;
        const int pb = ncc & 1;
        int ci = 0;
        for (; ci < nun; ++ci) {
            STG_LOAD(kc, vc, 64, 64 * (ci + 1));
            chunk_compute<2, 16, false>(KSBUF((ci + pb) & 1), VTBUF((ci + pb) & 1), qf, m, l, O, L, onesf, tq0, sl2, 16 * (64 * ci) + 31, 1 << 30, 0xFu, c, quad, imp_rows, 16 * ci, linv);
            STG_STORE((ci + 1 + pb) & 1);
            __syncthreads();
        }
        for (; ci < ncc; ++ci) {
            if (ci + 1 < ncc) STG_LOAD(kc, vc, 64, 64 * (ci + 1)); else STG_LOAD(ksl, vsl, NSA_LD, 0);
            chunk_compute<2, 16, true>(KSBUF((ci + pb) & 1), VTBUF((ci + pb) & 1), qf, m, l, O, L, onesf, tq0, sl2, 16 * (64 * ci) + 31, 1 << 30, 0xFu, c, quad, imp_rows, 16 * ci, linv);
            STG_STORE((ci + 1 + pb) & 1);
            __syncthreads();
        }
    }
#pragma unroll
    for (int qt = 0; qt < NQT; ++qt) {
        LAS f32x4* ol = (LAS f32x4*)(lds + OACC_OFF) + ((w * NQT + qt) * 4) * 64 + lane;
#pragma unroll
        for (int dt = 0; dt < 4; ++dt) ol[dt * 64] = O[qt][dt] * GATE(qt, 0);
    }
    {
        const int ql = lane >> 4, sub = lane & 15; const int cur = (t0 + 4 * w + ql) >> 6;
        float v[8];
#pragma unroll
        for (int i = 0; i < 8; ++i) { const int jb = sub + 16 * i; const float x = imp_rows[ql * 128 + jb]; const bool forced = (jb == 0) || (jb == cur) || (jb == cur - 1); v[i] = forced ? -2.0f : (jb <= cur ? x : -1.0f); }
        unsigned mk0 = 1u, mk1 = 0u, mk2 = 0u, mk3 = 0u;
        { const int wd = cur >> 5; const unsigned bit = 1u << (cur & 31); mk0 |= (wd == 0) ? bit : 0u; mk1 |= (wd == 1) ? bit : 0u; mk2 |= (wd == 2) ? bit : 0u; mk3 |= (wd == 3) ? bit : 0u; }
        if (cur >= 1) { const int pj = cur - 1; const int wd = pj >> 5; const unsigned bit = 1u << (pj & 31); mk0 |= (wd == 0) ? bit : 0u; mk1 |= (wd == 1) ? bit : 0u; mk2 |= (wd == 2) ? bit : 0u; mk3 |= (wd == 3) ? bit : 0u; }
        const int nforced = (cur >= 2) ? 3 : cur + 1;
        for (int round = nforced; round < 16; ++round) {
            float bv = v[0]; int bi = sub;
#pragma unroll
            for (int i = 1; i < 8; ++i) if (v[i] > bv) { bv = v[i]; bi = sub + 16 * i; }
            { float ov = dppf<DPP_X1>(bv); int oi = dppi<DPP_X1>(bi); if (ov > bv || (ov == bv && oi < bi)) { bv = ov; bi = oi; }
              ov = dppf<DPP_X2>(bv); oi = dppi<DPP_X2>(bi); if (ov > bv || (ov == bv && oi < bi)) { bv = ov; bi = oi; }
              ov = dppf<DPP_HM>(bv); oi = dppi<DPP_HM>(bi); if (ov > bv || (ov == bv && oi < bi)) { bv = ov; bi = oi; }
              ov = dppf<DPP_RM>(bv); oi = dppi<DPP_RM>(bi); if (ov > bv || (ov == bv && oi < bi)) { bv = ov; bi = oi; } }
            if (!__any(bv >= 0.f ? 1 : 0)) break;
            if (bv >= 0.f) { const unsigned bit = 1u << (bi & 31); const int wd = bi >> 5; mk0 |= (wd == 0) ? bit : 0u; mk1 |= (wd == 1) ? bit : 0u; mk2 |= (wd == 2) ? bit : 0u; mk3 |= (wd == 3) ? bit : 0u;
#pragma unroll
                for (int i = 0; i < 8; ++i) if (bi == sub + 16 * i) v[i] = -2.0f; }
        }
        if (sub == 0) { selm[(4 * w + ql) * 4 + 0] = mk0; selm[(4 * w + ql) * 4 + 1] = mk1; selm[(4 * w + ql) * 4 + 2] = mk2; selm[(4 * w + ql) * 4 + 3] = mk3; }
    }
    __syncthreads();
    if (tid < 4) { unsigned u = 0u; for (int q = 0; q < UQ; ++q) u |= selm[q * 4 + tid]; uni[tid] = u; }
    __syncthreads();
    int wpb = 0;
    {
        unsigned long long um0 = ((unsigned long long)uni[1] << 32) | uni[0], um1 = ((unsigned long long)uni[3] << 32) | uni[2];
        { const int cmx = (t0 + UQ - 1) >> 6; if (cmx < 63) { um0 &= (2ull << cmx) - 1ull; um1 = 0ull; } else if (cmx == 63) { um1 = 0ull; } else if (cmx < 127) { um1 &= (2ull << (cmx - 64)) - 1ull; } }
        um0 = ((unsigned long long)__builtin_amdgcn_readfirstlane((unsigned)(um0 >> 32)) << 32) | (unsigned)__builtin_amdgcn_readfirstlane((unsigned)um0);
        um1 = ((unsigned long long)__builtin_amdgcn_readfirstlane((unsigned)(um1 >> 32)) << 32) | (unsigned)__builtin_amdgcn_readfirstlane((unsigned)um1);
#pragma unroll
        for (int qt = 0; qt < NQT; ++qt) { m[qt] = MFLOOR; l[qt] = 0.f; L[qt] = (f32x4){0.f, 0.f, 0.f, 0.f};
#pragma unroll
            for (int dt = 0; dt < 4; ++dt) O[qt][dt] = (f32x4){0.f, 0.f, 0.f, 0.f}; }
        int jb = 0; um0 &= ~1ull; int bufi = 0;
        for (;;) {
            int jn = -1;
            if (um0) { jn = __builtin_ctzll(um0); um0 &= um0 - 1ull; } else if (um1) { jn = 64 + __builtin_ctzll(um1); um1 &= um1 - 1ull; }
            if (jn < 0) break;
            STG_LOAD(ksl, vsl, NSA_LD, 64 * jn);
            unsigned selbits = 0u;
#pragma unroll
            for (int qt = 0; qt < NQT; ++qt) { const unsigned wv = selm[(2 * NQT * w + qt * 2 + (c >> 3)) * 4 + (jb >> 5)]; selbits |= ((wv >> (jb & 31)) & 1u) << qt; }
            chunk_compute<0, 1, false, true>(KSBUF(bufi), VTBUF(bufi), qf, m, l, O, L, onesf, tq0, sl2, 64 * jb, 1 << 30, selbits, c, quad, imp_rows, 0, linv);
            STG_STORE(bufi ^ 1);
            __syncthreads();
            jb = jn; bufi ^= 1;
        }
        {
            unsigned selbits = 0u;
#pragma unroll
            for (int qt = 0; qt < NQT; ++qt) { const unsigned wv = selm[(2 * NQT * w + qt * 2 + (c >> 3)) * 4 + (jb >> 5)]; selbits |= ((wv >> (jb & 31)) & 1u) << qt; }
            STG_LOAD(kwp, vwp, NSA_LD, t0 - 512 + 64 * c0);
            chunk_compute<0, 1, true, true>(KSBUF(bufi), VTBUF(bufi), qf, m, l, O, L, onesf, tq0, sl2, 64 * jb, 1 << 30, selbits, c, quad, imp_rows, 0, linv);
            STG_STORE(bufi ^ 1);
            __syncthreads();
        }
        wpb = bufi ^ 1;
#pragma unroll
        for (int qt = 0; qt < NQT; ++qt) {
            float lt = L[qt][0]; lt = xsum32(xsum16(lt)); const float sc = (lt > 0.f ? 1.0f / lt : 0.f) * GATE(qt, 1);
            LAS f32x4* ol = (LAS f32x4*)(lds + OACC_OFF) + ((w * NQT + qt) * 4) * 64 + lane;
#pragma unroll
            for (int dt = 0; dt < 4; ++dt) { const f32x4 prev = ol[dt * 64]; ol[dt * 64] = prev + O[qt][dt] * sc; }
        }
    }
    {
#pragma unroll
        for (int qt = 0; qt < NQT; ++qt) { m[qt] = MFLOOR; l[qt] = 0.f; L[qt] = (f32x4){0.f, 0.f, 0.f, 0.f};
#pragma unroll
            for (int dt = 0; dt < 4; ++dt) O[qt][dt] = (f32x4){0.f, 0.f, 0.f, 0.f}; }
#define WIN_ITER(MSK_) do { const int bsel = (ci - c0 + wpb) & 1; STG_LOAD(kwp, vwp, NSA_LD, t0 - 512 + 64 * (ci + 1)); \
            chunk_compute<0, 1, MSK_>(KSBUF(bsel), VTBUF(bsel), qf, m, l, O, L, onesf, tq0, sl2, t0 - 512 + 64 * ci, 512, 0xFu, c, quad, imp_rows, 0, linv); \
            STG_STORE(bsel ^ 1); __syncthreads(); } while (0)
        int ci = c0;
        if (ci < 8) { WIN_ITER(true); ++ci; }
        for (; ci < 8; ++ci) WIN_ITER(false);
#undef WIN_ITER
        chunk_compute<0, 1, true>(KSBUF((8 - c0 + wpb) & 1), VTBUF((8 - c0 + wpb) & 1), qf, m, l, O, L, onesf, tq0, sl2, t0, 512, 0xFu, c, quad, imp_rows, 0, linv);
        __syncthreads();
#pragma unroll
        for (int qt = 0; qt < NQT; ++qt) {
            float lt = L[qt][0]; lt = xsum32(xsum16(lt)); const float sc = (lt > 0.f ? 1.0f / lt : 0.f) * GATE(qt, 2);
            int eoff = (tq0 + 2 * qt) * DM + head * 64 + quad * 4; asm volatile("" : "+v"(eoff));
            LAS const f32x4* ol = (LAS const f32x4*)(lds + OACC_OFF) + ((w * NQT + qt) * 4) * 64 + lane;
            bf16_t* orow = Obuf + (size_t)b * SEQ * DM + eoff;
#pragma unroll
            for (int dt = 0; dt < 4; ++dt) { const f32x4 o = ol[dt * 64] + O[qt][dt] * sc; u32x2 pk; pk.x = pk2(o[0], o[1]); pk.y = pk2(o[2], o[3]); *(u32x2*)(orow + dt * 16) = pk; }
        }
    }
}

constexpr int PH_PER_LAYER = 16;
__device__ __forceinline__ bool phase_exists(int L, int k) {
    if (L >= DEPTH || k > 11) return false;
    if (k == 0) return L == 0;
    if (k >= 2 && k <= 4) return (L & 1) != 0;
    return true;
}
template <int PHM>
__device__ __forceinline__ void run_phases(const Args& a, LAS unsigned char* lds) {
    volatile LAS unsigned* bst = (volatile LAS unsigned*)(lds + 131072 + 64);
    if (threadIdx.x == 0) { bst[0] = 0u; bst[1] = 0u; }
    __syncthreads();
    XcdBarrier xbar = xcd_barrier_post((unsigned*)(a.ws + WS_CTL), bst);
    int rep = 0, nsync = 0;
    for (int ph = a.ph_lo; ph < a.ph_hi; ++ph) {
        int tid = threadIdx.x; asm volatile("" : "+v"(tid));
        int bid = blockIdx.x; asm volatile("" : "+s"(bid));
        int G = gridDim.x; asm volatile("" : "+s"(G));
        size_t zoff = 0; asm volatile("" : "+s"(zoff)); unsigned char* ws = a.ws + zoff;
        const int lane = tid & 63, wave = __builtin_amdgcn_readfirstlane(tid >> 6);
        const int gw = bid * 8 + wave, NGW = G * 8, gtid = bid * 512 + tid, NT = G * 512;
        bf16_t* WIN = (bf16_t*)(ws + WS_WIN); bf16_t* WO = (bf16_t*)(ws + WS_WO); bf16_t* WGU = (bf16_t*)(ws + WS_WGU); bf16_t* WDN = (bf16_t*)(ws + WS_WDN); bf16_t* WC1 = (bf16_t*)(ws + WS_WC1);
        bf16_t* H = (bf16_t*)(ws + WS_H); bf16_t* PROJ = (bf16_t*)(ws + WS_PROJ); bf16_t* OB = (bf16_t*)(ws + WS_O); float* MIX = (float*)(ws + WS_MIX); bf16_t* MIXB = (bf16_t*)(ws + WS_MIX);
        bf16_t* ACMP = (bf16_t*)(ws + WS_ACMP); bf16_t* HID = (bf16_t*)(ws + WS_HID); bf16_t* KVC = (bf16_t*)(ws + WS_KVC); bf16_t* ACT = (bf16_t*)(ws + WS_ACT); bf16_t* SBG0 = (bf16_t*)(ws + WS_GU); bf16_t* SBU0 = SBG0 + (size_t)(MTOK / 64) * 2 * DFF; bf16_t* SBG1 = SBU0 + (size_t)(MTOK / 64) * 2 * DFF;
        const float* norm_g = a.in[1];
        const int L = ph / PH_PER_LAYER, k = ph % PH_PER_LAYER;
        if (!phase_exists(L, k)) continue;
        const int j = L >> 1; const bool nsa = (L & 1) != 0;
        const float* gL = norm_g + (size_t)L * 4 * DM;
#ifndef DUPM
#define DUPM 0
#endif
#ifndef DUPPAR
#define DUPPAR 3
#endif
        const int nrep = (((DUPM >> k) & 1) && ((DUPPAR >> (L & 1)) & 1)) ? 2 : 1;
        const int kk = ((PHM >> k) & 1) ? k : -1;
        switch (kk) {
        case 0: { convert_weights(a, 0, lds, gw, NGW, wave, lane); row_phase(nullptr, a.in[0], nullptr, nullptr, gL, H, gw, NGW, lane); } break;
        case 1: case 6: case 10: {
            pg8::Gemm g; pg8::EpiBf16<0> E; int N;
            if (k == 1) { N = nsa ? NSA_LD : SWA_N; g = pg8::Gemm{H, WIN, MTOK, N, DM}; E = pg8::EpiBf16<0>{PROJ, N, nsa ? nullptr : a.in[3] + (size_t)j * SWA_N}; }
            else if (k == 6) { N = DM; g = pg8::Gemm{OB, WO, MTOK, DM, DM}; E = pg8::EpiBf16<0>{MIXB, DM, nsa ? nullptr : a.in[6] + (size_t)j * DM}; }
            else { N = DM; g = pg8::Gemm{ACT, WDN, MTOK, DM, DFF}; E = pg8::EpiBf16<0>{MIXB, DM, nullptr}; }
            pg8::StaticOrder S; S.init(MTOK, N, G, bid);
            pg8::gemm_phase<pg8::EpiBf16<0>, pg8::StaticOrder, true, true>(lds, g, S, E, tid);
        } break;
        case 8: {
            pg8::Gemm g{H, WGU, MTOK, GU_N, DM};
            pg8::EpiAct E{ACT, DFF, a.in[16] + (size_t)L * 3 * DFF, a.in[17] + (size_t)L * DFF, SBG0, SBU0, SBG1};
            pg8::StaticOrder S; S.init(MTOK, GU_N, G, bid);
            pg8::gemm_phase<pg8::EpiAct, pg8::StaticOrder, true, true>(lds, g, S, E, tid);
        } break;
        case 2: cmp_build(PROJ, a.in[8] + (size_t)j * 2 * 32 * 64, ACMP, gtid, NT); break;
        case 3: {
            for (int kv = 0; kv < 2; ++kv) {
                pg8::Gemm g{ACMP + (size_t)kv * CMP_ROWS * 2048, WC1 + (size_t)kv * 512 * DM, CMP_ROWS, 512, DM};
                pg8::EpiBf16<2> E{HID + (size_t)kv * CMP_ROWS * 512, 512, a.in[10] + (size_t)(j * 2 + kv) * 512};
                pg8::StaticOrder S; S.init(CMP_ROWS, 512, G, (bid + G - 32 * kv) % G);
                pg8::gemm_phase<pg8::EpiBf16<2>, pg8::StaticOrder, true, true>(lds, g, S, E, tid);
            }
        } break;
        case 4: cmp_out(HID, a.in[11] + (size_t)j * 2 * 512 * 64, a.in[12] + (size_t)j * 2 * 64, KVC, lds, tid, gw, NGW); break;
        case 5: {
            for (int r = 0; r * G < NUNIT; ++r) {
                const int R = r * G + ((r & 1) ? (G - 1 - bid) : bid);
                if (R >= NUNIT) continue;
                const int unit = (R & 7) * QBN + (QBN - 1 - (R >> 3));
                if (nsa) nsa_unit(PROJ, KVC, MIX, OB, unit, lds, tid); else swa_unit(PROJ, a.in[4] + (size_t)j * 32, OB, unit, lds, tid);
            }
        } break;
        case 7: row_phase(MIXB, L == 0 ? a.in[0] : a.out, a.out, gL + DM, gL + 2 * DM, H, gw, NGW, lane); break;
        case 9: act_fixup(SBG0, SBU0, SBG1, ACT, a.in[16] + (size_t)L * 3 * DFF, a.in[17] + (size_t)L * DFF, gtid, NT); break;
        case 11: {
            row_phase(MIXB, a.out, a.out, gL + 3 * DM, (L + 1 < DEPTH) ? gL + 4 * DM : nullptr, H, gw, NGW, lane);
            if (L + 1 < DEPTH) { __syncthreads(); convert_weights(a, L + 1, lds, gw, NGW, wave, lane);
                if ((DUPM >> 12) & 1) { __syncthreads(); convert_weights(a, L + 1, lds, gw, NGW, wave, lane); } }
        } break;
        default: break;
        }
        if (a.coop) { bool more = false; for (int p2 = ph + 1; p2 < a.ph_hi; ++p2) if (phase_exists(p2 / PH_PER_LAYER, p2 % PH_PER_LAYER)) { more = true; break; } if (more) { if (a.coop < 0) cg::this_grid().sync(); else xcd_barrier(xbar); ++nsync; } }
        else __syncthreads();
        if (nrep == 2 && rep == 0) { rep = 1; --ph; } else rep = 0;
    }
    if ((DUPM >> 13) & 1) { for (int i = 0; i < 20; ++i) xcd_barrier(xbar); }
}
template <int PHM>
__global__ void __launch_bounds__(512, 2) fwd(Args a) {
    extern __shared__ __attribute__((aligned(16))) unsigned char lds_raw[];
    run_phases<PHM>(a, (LAS unsigned char*)lds_raw);
}

#ifndef ONE_LAUNCH
#define ONE_LAUNCH 1
#endif
constexpr int PHM_ALL = 0xFFF;
#if !ONE_LAUNCH
static const void* phase_kernel(int k) {
    switch (k) {
    case 0: return (const void*)fwd<1 << 0>;
    case 1: case 8: return (const void*)fwd<(1 << 1) | (1 << 8)>;
    case 2: return (const void*)fwd<1 << 2>;
    case 3: return (const void*)fwd<1 << 3>;
    case 4: return (const void*)fwd<1 << 4>;
    case 5: return (const void*)fwd<1 << 5>;
    case 6: case 10: return (const void*)fwd<(1 << 6) | (1 << 10)>;
    case 7: return (const void*)fwd<1 << 7>;
    case 9: return (const void*)fwd<1 << 9>;
    default: return (const void*)fwd<1 << 11>;
    }
}
#endif
extern "C" void kernel_launch(void* const* d_in, const int* in_sizes, int n_in, void* d_out, int out_size, void* d_ws, size_t ws_size, hipStream_t stream) {
    static int grid = 0;
    if (grid == 0) {
        if (n_in != 19 || out_size != MTOK * DM || ws_size < WS_END) { fprintf(stderr, "kernel_launch: unexpected shapes n_in %d out %d ws %zu (need %zu)\n", n_in, out_size, ws_size, (size_t)WS_END); grid = -1; return; }
        int dev = 0, cus = 0, per_cu = 0;
        (void)hipGetDevice(&dev); (void)hipDeviceGetAttribute(&cus, hipDeviceAttributeMultiprocessorCount, dev);
#if ONE_LAUNCH
        if (hipFuncSetAttribute((const void*)fwd<PHM_ALL>, hipFuncAttributeMaxDynamicSharedMemorySize, LDS_BYTES) != hipSuccess) { fprintf(stderr, "kernel_launch: hipFuncSetAttribute failed\n"); grid = -1; return; }
        (void)hipOccupancyMaxActiveBlocksPerMultiprocessor(&per_cu, (const void*)fwd<PHM_ALL>, 512, LDS_BYTES);
#else
        for (int k = 0; k < 12; ++k) if (hipFuncSetAttribute(phase_kernel(k), hipFuncAttributeMaxDynamicSharedMemorySize, LDS_BYTES) != hipSuccess) { fprintf(stderr, "kernel_launch: hipFuncSetAttribute failed\n"); grid = -1; return; }
#endif
        (void)hipGetLastError();
        grid = cus > 0 ? cus : 256;
        fprintf(stderr, "kernel_launch: grid %d (cus %d, per_cu %d), ws %zu\n", grid, cus, per_cu, ws_size);
    }
    if (grid < 0) return;
    Args a{};
    for (int i = 0; i < 19; ++i) a.in[i] = (const float*)d_in[i];
    a.out = (float*)d_out; a.ws = (unsigned char*)d_ws;
#if ONE_LAUNCH
    (void)hipMemsetAsync((char*)d_ws + WS_CTL, 0, CTL_BYTES, stream);
    a.ph_lo = 0; a.ph_hi = DEPTH * PH_PER_LAYER; a.coop = 1;
    void* kargs[] = {&a};
    hipError_t e = hipLaunchCooperativeKernel((const void*)fwd<PHM_ALL>, dim3(grid), dim3(512), kargs, LDS_BYTES, stream);
    if (e != hipSuccess) fprintf(stderr, "cooperative launch failed: %s (grid %d)\n", hipGetErrorString(e), grid);
#else
    for (int ph = 0; ph < DEPTH * PH_PER_LAYER; ++ph) {
        const int L = ph / PH_PER_LAYER, k = ph % PH_PER_LAYER;
        if (L >= DEPTH || k > 11 || (k == 0 && L != 0) || (k >= 2 && k <= 4 && !(L & 1))) continue;
        a.ph_lo = ph; a.ph_hi = ph + 1; a.coop = 0;
        void* kargs[] = {&a};
        hipError_t e = hipLaunchKernel(phase_kernel(k), dim3(grid), dim3(512), kargs, LDS_BYTES, stream);
        if (e != hipSuccess) { fprintf(stderr, "launch failed: %s (phase %d)\n", hipGetErrorString(e), ph); break; }
    }
#endif
}
```

```cpp
#include <hip/hip_runtime.h>
#include <hip/hip_cooperative_groups.h>
#include <cstdio>
#include <cstdint>
namespace cg = cooperative_groups;
namespace pg8 {
#define PG8_LAS __attribute__((address_space(3)))
typedef unsigned short bf16_t;
typedef short bf16x8 __attribute__((ext_vector_type(8)));
typedef float f32x4 __attribute__((ext_vector_type(4)));
typedef unsigned u32x4 __attribute__((ext_vector_type(4)));
constexpr int BM = 256, BK = 64, HALF = 128, HTB = HALF * BK * 2  , STAGE_BYTES = 8 * HTB, NXCD = 8, WGM = 8;

__host__ __device__ __forceinline__ int lds_byte(int r, int c) { const int st = (r >> 4) * 2 + (c >> 5), rr = r & 15, cc = c & 31, ob = rr * 64 + cc * 2; return st * 1024 + (ob ^ (((ob >> 9) & 1) << 5)); }
__host__ __device__ __forceinline__ void stage_rc(int b, int& R, int& C) { const int st = b / 1024, sb = b % 1024, swz = sb ^ (((sb >> 9) & 1) << 5); R = (st >> 1) * 16 + swz / 64; C = (st & 1) * 32 + (swz % 64) / 2; }
__host__ __device__ __forceinline__ int perm32(int rho) { const int n = rho >> 4, i = rho & 15; return 8 * (i >> 2) + 4 * n + (i & 3); }

struct Unit { int pm, pn; };
struct Gemm { const bf16_t* A; const bf16_t* Bt; int M, N, K; };

struct StaticOrder {
    int nM, nN, nwg, G, c;
    __host__ __device__ void init(int M, int N, int G_, int c_) { nM = M / BM; nN = N / BM; nwg = nM * nN; G = G_; c = c_; }
    __host__ __device__ bool next(int i, Unit& u) const {
        const long L = (long)i * G + c; if (L >= nwg) return false;
        int wgid = (int)L; { const int q = nwg / NXCD, r = nwg % NXCD, xcd = wgid % NXCD, off = wgid / NXCD; wgid = (xcd < r ? xcd * (q + 1) : r * (q + 1) + (xcd - r) * q) + off; }
        const int nig = WGM * nN, gid = wgid / nig, fm = gid * WGM, gsz = (nM - fm) < WGM ? (nM - fm) : WGM;
        u.pm = fm + ((wgid % nig) % gsz); u.pn = (wgid % nig) / gsz; return true;
    }
    __device__ __forceinline__ void a_ready(const Unit&) const {}
    __device__ __forceinline__ void done(const Unit&) const {}
};

__device__ __forceinline__ unsigned cvt_pk_bf16(float lo, float hi) { unsigned r; asm volatile("v_cvt_pk_bf16_f32 %0, %1, %2" : "=v"(r) : "v"(lo), "v"(hi)); return r; }
__device__ __forceinline__ float gelu_tanh(float x) { const float u = 0.7978845608028654f * (x + 0.044715f * x * x * x); return x * __builtin_amdgcn_rcpf(1.0f + __builtin_amdgcn_exp2f(-2.0f * 1.4426950408889634f * u)); }
template <int ACT> struct EpiBf16 {
    static constexpr bool PERM = true, AFTER_DRAIN = false;
    bf16_t* O; int ldc; const float* bias;
    __device__ __forceinline__ void operator()(const f32x4 (&acc)[2][2][4][2], const Unit& u, int wr, int wc, int fr, int fq) const {
        const int row0 = u.pm * BM + wr * 64 + fr; const int col0 = u.pn * BM + wc * 32 + 8 * fq;
        f32x4 bv[2][2];
#pragma unroll
        for (int bj = 0; bj < 2; ++bj)
#pragma unroll
            for (int n = 0; n < 2; ++n) bv[bj][n] = bias ? *(const f32x4*)(bias + col0 + bj * HALF + 4 * n) : (f32x4){0.f, 0.f, 0.f, 0.f};
#pragma unroll
        for (int ai = 0; ai < 2; ++ai)
#pragma unroll
            for (int m = 0; m < 4; ++m) { bf16_t* rowp = O + (size_t)(row0 + ai * HALF + m * 16) * ldc + col0;
#pragma unroll
                for (int bj = 0; bj < 2; ++bj) { f32x4 v0 = acc[ai][bj][m][0] + bv[bj][0], v1 = acc[ai][bj][m][1] + bv[bj][1];
                    if (ACT == 2) { v0 = (f32x4){gelu_tanh(v0[0]), gelu_tanh(v0[1]), gelu_tanh(v0[2]), gelu_tanh(v0[3])}; v1 = (f32x4){gelu_tanh(v1[0]), gelu_tanh(v1[1]), gelu_tanh(v1[2]), gelu_tanh(v1[3])}; }
                    u32x4 w; w.x = cvt_pk_bf16(v0[0], v0[1]); w.y = cvt_pk_bf16(v0[2], v0[3]); w.z = cvt_pk_bf16(v1[0], v1[1]); w.w = cvt_pk_bf16(v1[2], v1[3]);
                    *(u32x4*)(rowp + bj * HALF) = w; } }
    }
};
struct EpiF32 {
    static constexpr bool PERM = false, AFTER_DRAIN = false;
    float* O; int ldc; const float* bias;
    __device__ __forceinline__ void operator()(const f32x4 (&acc)[2][2][4][2], const Unit& u, int wr, int wc, int fr, int fq) const {
        const int row0 = u.pm * BM + wr * 64 + fr; const int col0 = u.pn * BM + wc * 32 + 4 * fq;
        f32x4 bv[2][2];
#pragma unroll
        for (int bj = 0; bj < 2; ++bj)
#pragma unroll
            for (int n = 0; n < 2; ++n) bv[bj][n] = bias ? *(const f32x4*)(bias + col0 + bj * HALF + 16 * n) : (f32x4){0.f, 0.f, 0.f, 0.f};
#pragma unroll
        for (int ai = 0; ai < 2; ++ai)
#pragma unroll
            for (int m = 0; m < 4; ++m) { float* rowp = O + (size_t)(row0 + ai * HALF + m * 16) * ldc + col0;
#pragma unroll
                for (int bj = 0; bj < 2; ++bj)
#pragma unroll
                    for (int n = 0; n < 2; ++n) *(f32x4*)(rowp + bj * HALF + 16 * n) = acc[ai][bj][m][n] + bv[bj][n]; }
    }
};

__device__ __forceinline__ float dpp_f(float oldv, float src, const int ctrl_sel) {
    const int o = __builtin_bit_cast(int, oldv), s = __builtin_bit_cast(int, src); int r;
    if (ctrl_sel == 0) r = __builtin_amdgcn_update_dpp(o, s, 0x121, 0xF, 0xF, false);
    else if (ctrl_sel == 1) r = __builtin_amdgcn_update_dpp(o, s, 0x111, 0xF, 0xF, false);
    else if (ctrl_sel == 2) r = __builtin_amdgcn_update_dpp(o, s, 0x122, 0xF, 0xF, false);
    else r = __builtin_amdgcn_update_dpp(o, s, 0x112, 0xF, 0xF, false);
    return __builtin_bit_cast(float, r);
}
struct EpiAct {
    static constexpr bool PERM = true, AFTER_DRAIN = false;
    bf16_t* ACT; int dff; const float* cw; const float* cb; bf16_t* SBG0; bf16_t* SBU0; bf16_t* SBG1;
    __device__ __forceinline__ void operator()(const f32x4 (&acc)[2][2][4][2], const Unit& u, int wr, int wc, int fr, int fq) const {
        const int f0 = u.pn * HALF + wc * 32 + 8 * fq;
        float w0[8], w1[8], w2[8], bb[8];
#pragma unroll
        for (int h = 0; h < 2; ++h) { const f32x4 a0 = *(const f32x4*)(cw + f0 + 4 * h), a1 = *(const f32x4*)(cw + dff + f0 + 4 * h), a2 = *(const f32x4*)(cw + 2 * dff + f0 + 4 * h), a3 = *(const f32x4*)(cb + f0 + 4 * h);
#pragma unroll
            for (int e = 0; e < 4; ++e) { w0[4 * h + e] = a0[e]; w1[4 * h + e] = a1[e]; w2[4 * h + e] = a2[e]; bb[4 * h + e] = a3[e]; } }
#pragma unroll
        for (int ai = 0; ai < 2; ++ai) {
            const int grp = u.pm * 4 + ai * 2 + wr;
            float pg[8];
#pragma unroll
            for (int e = 0; e < 8; ++e) pg[e] = 0.f;
#pragma unroll
            for (int m = 0; m < 4; ++m) {
                float g[8], up[8], o[8];
#pragma unroll
                for (int e = 0; e < 8; ++e) { g[e] = acc[ai][0][m][e >> 2][e & 3]; up[e] = acc[ai][1][m][e >> 2][e & 3]; }
#pragma unroll
                for (int e = 0; e < 8; ++e) {
                    const float t1 = dpp_f(0.f, pg[e], 0); const float g1 = dpp_f(t1, g[e], 1);
                    const float t2 = dpp_f(0.f, pg[e], 2); const float g2 = dpp_f(t2, g[e], 3);
                    const float av = bb[e] + w0[e] * g2 + w1[e] * g1 + w2[e] * g[e];
                    o[e] = av * __builtin_amdgcn_rcpf(1.0f + __builtin_amdgcn_exp2f(-1.4426950408889634f * av)) * up[e];
                }
                const int row = u.pm * BM + ai * HALF + wr * 64 + m * 16 + fr;
                u32x4 ov; ov.x = cvt_pk_bf16(o[0], o[1]); ov.y = cvt_pk_bf16(o[2], o[3]); ov.z = cvt_pk_bf16(o[4], o[5]); ov.w = cvt_pk_bf16(o[6], o[7]);
                *(u32x4*)(ACT + (size_t)row * dff + f0) = ov;
                if (m == 0 && fr < 2) {
                    u32x4 gv; gv.x = cvt_pk_bf16(g[0], g[1]); gv.y = cvt_pk_bf16(g[2], g[3]); gv.z = cvt_pk_bf16(g[4], g[5]); gv.w = cvt_pk_bf16(g[6], g[7]);
                    u32x4 uv; uv.x = cvt_pk_bf16(up[0], up[1]); uv.y = cvt_pk_bf16(up[2], up[3]); uv.z = cvt_pk_bf16(up[4], up[5]); uv.w = cvt_pk_bf16(up[6], up[7]);
                    *(u32x4*)(SBG0 + (size_t)(grp * 2 + fr) * dff + f0) = gv; *(u32x4*)(SBU0 + (size_t)(grp * 2 + fr) * dff + f0) = uv;
                }
                if (m == 3 && fr >= 14) {
                    u32x4 gv; gv.x = cvt_pk_bf16(g[0], g[1]); gv.y = cvt_pk_bf16(g[2], g[3]); gv.z = cvt_pk_bf16(g[4], g[5]); gv.w = cvt_pk_bf16(g[6], g[7]);
                    *(u32x4*)(SBG1 + (size_t)(grp * 2 + fr - 14) * dff + f0) = gv;
                }
#pragma unroll
                for (int e = 0; e < 8; ++e) pg[e] = g[e];
            }
        }
    }
};
template <class Epi, class Sched, bool ALIGN_EPI = false, bool SP2 = false>
__device__ __forceinline__ void gemm_phase(PG8_LAS unsigned char* lds, const Gemm g, const Sched& S, const Epi& E, const int tid) {
    const int wid = __builtin_amdgcn_readfirstlane(tid >> 6), lane = tid & 63, wr = wid >> 2, wc = wid & 3, fr = lane & 15, fq = lane >> 4;
    const int K = g.K, nt = K / BK;
    unsigned voffA[2], voffB[2];
#pragma unroll
    for (int i = 0; i < 2; ++i) { int R, C; stage_rc(tid * 16 + i * 8192, R, C); const int Rb = Epi::PERM ? ((R & ~31) + perm32(R & 31)) : R;
        voffA[i] = (unsigned)(R * K + C) * 2u; voffB[i] = (unsigned)(Rb * K + C) * 2u; }
    const size_t kstep = (size_t)(BK * 2);
    const size_t hstep = (size_t)HALF * K * 2;
    const size_t tstep = 2 * hstep;
    const unsigned ldsw = (unsigned)wid * 1024u;
    const int aoff = lds_byte(wr * 64 + fr, fq * 8), boff = lds_byte(wc * 32 + fr, fq * 8);
#define PG8_SA(b, h) (((b) * 2 + (h)) * HTB)
#define PG8_SB(b, h) ((4 + (b) * 2 + (h)) * HTB)
#define PG8_STAGE(bufoff, gbase, voff) do { _Pragma("unroll") for (int _i = 0; _i < 2; ++_i) \
        __builtin_amdgcn_global_load_lds((const unsigned*)((const char*)(gbase) + (voff)[_i]), (PG8_LAS unsigned*)(lds + (bufoff) + ldsw + _i * 8192), 16, 0, 0); } while (0)
#define PG8_LDA(dst, b, h) do { _Pragma("unroll") for (int m = 0; m < 4; ++m) _Pragma("unroll") for (int k = 0; k < 2; ++k) dst[m][k] = *(const PG8_LAS bf16x8*)(lds + PG8_SA(b, h) + aoff + m * 2048 + k * 1024); } while (0)
#define PG8_LDB(dst, b, h) do { _Pragma("unroll") for (int n = 0; n < 2; ++n) _Pragma("unroll") for (int k = 0; k < 2; ++k) dst[n][k] = *(const PG8_LAS bf16x8*)(lds + PG8_SB(b, h) + boff + n * 2048 + k * 1024); } while (0)
#define PG8_MMA(ai, bj, At, Bt) do { __builtin_amdgcn_s_setprio(1); _Pragma("unroll") for (int m = 0; m < 4; ++m) _Pragma("unroll") for (int n = 0; n < 2; ++n) _Pragma("unroll") for (int k = 0; k < 2; ++k) \
        acc[ai][bj][m][n] = __builtin_amdgcn_mfma_f32_16x16x32_bf16(Bt[n][k], At[m][k], acc[ai][bj][m][n], 0, 0, 0); __builtin_amdgcn_s_setprio(0); } while (0)
#define PG8_WAIT_V(n) asm volatile("s_waitcnt vmcnt(" #n ")" ::: "memory")
#define PG8_WAIT_L(n) asm volatile("s_waitcnt lgkmcnt(" #n ")" ::: "memory")
#define PG8_BAR __builtin_amdgcn_s_barrier()
#define PG8_SCHED __builtin_amdgcn_sched_barrier(0)
    Unit cur, nxt; int ui = 0;
    if (!S.next(0, cur)) return;
    f32x4 acc[2][2][4][2];
#pragma unroll
    for (int a = 0; a < 2; ++a)
#pragma unroll
        for (int b = 0; b < 2; ++b)
#pragma unroll
            for (int m = 0; m < 4; ++m)
#pragma unroll
                for (int n = 0; n < 2; ++n) acc[a][b][m][n] = (f32x4){0.f, 0.f, 0.f, 0.f};
    bf16x8 At[4][2], B0[2][2], B1[2][2];
    const char* cA = (const char*)g.A + (size_t)cur.pm * tstep; const char* cB = (const char*)g.Bt + (size_t)cur.pn * tstep;
    S.a_ready(cur);
    if constexpr (SP2) {
        PG8_STAGE(PG8_SB(0, 0), cB, voffB); PG8_STAGE(PG8_SB(0, 1), cB + hstep, voffB); PG8_STAGE(PG8_SA(0, 0), cA, voffA); PG8_STAGE(PG8_SA(0, 1), cA + hstep, voffA);
        if (wr == 1) PG8_BAR;
        PG8_WAIT_V(2); PG8_BAR;
        PG8_STAGE(PG8_SB(1, 0), cB + kstep, voffB); PG8_STAGE(PG8_SA(1, 0), cA + kstep, voffA); PG8_STAGE(PG8_SB(1, 1), cB + hstep + kstep, voffB);
        PG8_WAIT_V(6); PG8_BAR;
    } else {
        PG8_STAGE(PG8_SB(0, 0), cB, voffB); PG8_STAGE(PG8_SA(0, 0), cA, voffA); PG8_STAGE(PG8_SB(0, 1), cB + hstep, voffB); PG8_STAGE(PG8_SA(0, 1), cA + hstep, voffA);
        if (wr == 1) PG8_BAR;
        PG8_WAIT_V(4); PG8_BAR;
        PG8_STAGE(PG8_SB(1, 0), cB + kstep, voffB); PG8_STAGE(PG8_SA(1, 0), cA + kstep, voffA); PG8_STAGE(PG8_SB(1, 1), cB + hstep + kstep, voffB);
        PG8_WAIT_V(6); PG8_BAR;
    }
    for (;;) {
        const bool has_next = S.next(ui + 1, nxt);
        const char* nA = has_next ? (const char*)g.A + (size_t)nxt.pm * tstep : cA; const char* nB = has_next ? (const char*)g.Bt + (size_t)nxt.pn * tstep : cB;
        for (int t = 0; t < nt; t += 2) {
            const bool last = (t == nt - 2);
            const char* a1 = cA + (size_t)(t + 1) * kstep;
            const char* a2 = last ? nA : cA + (size_t)(t + 2) * kstep; const char* b2 = last ? nB : cB + (size_t)(t + 2) * kstep;
            const char* a3 = a2 + kstep; const char* b3 = b2 + kstep;
            if (last && has_next) S.a_ready(nxt);
            if constexpr (SP2) {
            PG8_LDB(B0, 0, 0); PG8_LDB(B1, 0, 1); PG8_SCHED; PG8_LDA(At, 0, 0); PG8_STAGE(PG8_SA(1, 1), a1 + hstep, voffA);
            PG8_WAIT_V(8); PG8_WAIT_L(0); PG8_BAR; PG8_MMA(0, 0, At, B0); PG8_MMA(0, 1, At, B1); PG8_BAR; PG8_SCHED;
            PG8_LDA(At, 0, 1); PG8_STAGE(PG8_SB(0, 0), b2, voffB); PG8_STAGE(PG8_SB(0, 1), b2 + hstep, voffB); PG8_STAGE(PG8_SA(0, 0), a2, voffA);
            PG8_WAIT_V(8); PG8_WAIT_L(0); PG8_BAR; PG8_MMA(1, 0, At, B0); PG8_MMA(1, 1, At, B1); PG8_BAR; PG8_SCHED;
            PG8_LDB(B0, 1, 0); PG8_LDB(B1, 1, 1); PG8_SCHED; PG8_LDA(At, 1, 0); PG8_STAGE(PG8_SA(0, 1), a2 + hstep, voffA);
            PG8_WAIT_V(8); PG8_WAIT_L(0); PG8_BAR; PG8_MMA(0, 0, At, B0); PG8_MMA(0, 1, At, B1); PG8_BAR; PG8_SCHED;
            PG8_LDA(At, 1, 1); PG8_STAGE(PG8_SB(1, 0), b3, voffB); PG8_STAGE(PG8_SB(1, 1), b3 + hstep, voffB); PG8_STAGE(PG8_SA(1, 0), a3, voffA);
            PG8_WAIT_V(8); PG8_WAIT_L(0); PG8_BAR; PG8_MMA(1, 0, At, B0); PG8_MMA(1, 1, At, B1); PG8_BAR; PG8_SCHED;
            } else {
            PG8_LDB(B0, 0, 0); PG8_SCHED; PG8_LDA(At, 0, 0); PG8_STAGE(PG8_SA(1, 1), a1 + hstep, voffA);
            PG8_WAIT_L(8); PG8_BAR; PG8_WAIT_L(0); PG8_MMA(0, 0, At, B0); PG8_BAR; PG8_SCHED;
            PG8_LDB(B1, 0, 1); PG8_STAGE(PG8_SB(0, 0), b2, voffB);
            PG8_BAR; PG8_WAIT_L(0); PG8_MMA(0, 1, At, B1); PG8_BAR;
            PG8_LDA(At, 0, 1); PG8_STAGE(PG8_SA(0, 0), a2, voffA);
            PG8_BAR; PG8_WAIT_L(0); PG8_MMA(1, 0, At, B0); PG8_BAR; PG8_SCHED;
            PG8_STAGE(PG8_SB(0, 1), b2 + hstep, voffB);
            PG8_WAIT_V(6); PG8_BAR; PG8_MMA(1, 1, At, B1); PG8_BAR;
            PG8_LDB(B0, 1, 0); PG8_SCHED; PG8_LDA(At, 1, 0); PG8_STAGE(PG8_SA(0, 1), a2 + hstep, voffA);
            PG8_WAIT_L(8); PG8_BAR; PG8_WAIT_L(0); PG8_MMA(0, 0, At, B0); PG8_BAR; PG8_SCHED;
            PG8_LDB(B1, 1, 1); PG8_STAGE(PG8_SB(1, 0), b3, voffB);
            PG8_BAR; PG8_WAIT_L(0); PG8_MMA(0, 1, At, B1); PG8_BAR;
            PG8_LDA(At, 1, 1); PG8_STAGE(PG8_SA(1, 0), a3, voffA);
            PG8_BAR; PG8_WAIT_L(0); PG8_MMA(1, 0, At, B0); PG8_BAR; PG8_SCHED;
            PG8_STAGE(PG8_SB(1, 1), b3 + hstep, voffB);
            PG8_WAIT_V(6); PG8_BAR; PG8_MMA(1, 1, At, B1); PG8_BAR;
            }
        }
        if constexpr (ALIGN_EPI) { if (wr == 0) PG8_BAR; }
        if constexpr (!Epi::AFTER_DRAIN) { E(acc, cur, wr, wc, fr, fq); S.done(cur); }
        if (!has_next) break;
#pragma unroll
        for (int a = 0; a < 2; ++a)
#pragma unroll
            for (int b = 0; b < 2; ++b)
#pragma unroll
                for (int m = 0; m < 4; ++m)
#pragma unroll
                    for (int n = 0; n < 2; ++n) acc[a][b][m][n] = (f32x4){0.f, 0.f, 0.f, 0.f};
        cur = nxt; cA = nA; cB = nB; ++ui;
        if constexpr (ALIGN_EPI) { if (wr == 1) PG8_BAR; }
    }
    PG8_WAIT_V(0);
    if constexpr (!ALIGN_EPI) { if (wr == 0) PG8_BAR; }
    PG8_BAR;
    if constexpr (Epi::AFTER_DRAIN) { E.fused(acc, cur, wr, wc, fr, fq, lds, wid, lane); S.done(cur); }
#undef PG8_SA
#undef PG8_SB
#undef PG8_STAGE
#undef PG8_LDA
#undef PG8_LDB
#undef PG8_MMA
#undef PG8_WAIT_V
#undef PG8_WAIT_L
#undef PG8_BAR
#undef PG8_SCHED
}
}

#define LAS __attribute__((address_space(3)))
typedef unsigned short bf16_t;
typedef short bf16x8 __attribute__((ext_vector_type(8)));
typedef short s16x4 __attribute__((ext_vector_type(4)));
typedef float f32x4 __attribute__((ext_vector_type(4)));
typedef unsigned u32x4 __attribute__((ext_vector_type(4)));
typedef unsigned u32x2 __attribute__((ext_vector_type(2)));

constexpr int SEQ = 8192, NBATCH = 2, MTOK = NBATCH * SEQ, DM = 2048, DFF = 5632, DEPTH = 4;
constexpr int SWA_N = 2560, NSA_N = 3680, NSA_LD = 3840, GU_N = 2 * DFF;
constexpr int NCMP = 511, CMP_ROWS = 4096;
constexpr float RMS_EPS = 1e-6f, LOG2E = 1.4426950408889634f, QSC = 0.125f * 1.4426950408889634f;
constexpr size_t MiB = 1u << 20;
constexpr size_t WS_WIN = 0, WS_WO = 16 * MiB, WS_WGU = 24 * MiB, WS_WDN = 68 * MiB, WS_WC1 = 90 * MiB, WS_H = 96 * MiB;
constexpr size_t WS_PROJ = 160 * MiB, WS_O = 280 * MiB, WS_MIX = 344 * MiB, WS_ACMP = 472 * MiB, WS_HID = 504 * MiB, WS_KVC = 512 * MiB;
constexpr size_t WS_CTL = 94 * MiB, CTL_BYTES = 16384;
constexpr size_t WS_GU = 160 * MiB, WS_ACT = 520 * MiB, WS_END = 696 * MiB;
constexpr int ROWE = 80;
constexpr int KS_OFF = 0, KS_BYTES = 64 * ROWE * 2, VT_OFF = 2 * KS_BYTES, VT_BYTES = 64 * ROWE * 2, IMP_OFF = 2 * KS_BYTES + 2 * VT_BYTES, SELM_OFF = IMP_OFF + 16384, UNI_OFF = SELM_OFF + 1024, OACC_OFF = UNI_OFF + 1024;
static_assert(OACC_OFF + 65536 <= 131072, "attention LDS map");
constexpr int LDS_BYTES = 131072 + 1024;

struct Args { const float* in[19]; float* out; unsigned char* ws; int ph_lo, ph_hi, coop, pad; };

__device__ __forceinline__ float bf2f(unsigned short v) { return __uint_as_float(((unsigned)v) << 16); }
__device__ __forceinline__ float bflo(unsigned v) { return __uint_as_float(v << 16); }
__device__ __forceinline__ float bfhi(unsigned v) { return __uint_as_float(v & 0xffff0000u); }
typedef float f32x2_t __attribute__((ext_vector_type(2))); typedef __bf16 bf16x2_t __attribute__((ext_vector_type(2)));
__device__ __forceinline__ unsigned pk2(float lo, float hi) { f32x2_t v = {lo, hi}; bf16x2_t b = __builtin_convertvector(v, bf16x2_t); return __builtin_bit_cast(unsigned, b); }
__device__ __forceinline__ float wave_sum(float v) {
#pragma unroll
    for (int o = 1; o < 64; o <<= 1) v += __shfl_xor(v, o);
    return v;
}


#define GAS __attribute__((address_space(1)))
typedef GAS unsigned gu32;
#define XB_TMO      128
#define XB_XCNT(j)  (256  + 64 * (j))
#define XB_XSUB(j)  (1280 + 64 * (j))
#define XB_XGEN(j)  (2304 + 64 * (j))
#define XB_TOP      3328
#define XB_TOPGEN   3392
#define XCD_BAR_WORDS 3456
#define XB_SPIN_CAP (1u << 18)

__device__ __forceinline__ unsigned xb_ld(unsigned* p)              { return __hip_atomic_load(p, __ATOMIC_RELAXED, __HIP_MEMORY_SCOPE_AGENT); }
__device__ __forceinline__ unsigned xb_add(unsigned* p, unsigned v) { return __hip_atomic_fetch_add(p, v, __ATOMIC_RELAXED, __HIP_MEMORY_SCOPE_AGENT); }
__device__ __forceinline__ unsigned xb_xcc_id() { return (unsigned)__builtin_amdgcn_s_getreg((3 << 11) | 20) & 0xFu; }
#define XB_SPIN(cond, bar) do { unsigned _sp = 0; while (cond) { __builtin_amdgcn_s_sleep(1); \
    if ((++_sp & 255u) == 0u) { if (xb_ld(&(bar)[XB_TMO])) break; if (_sp > XB_SPIN_CAP) { atomicAdd(&(bar)[XB_TMO], 1u); break; } } } } while (0)

struct XcdBarrier {
    unsigned* bar; unsigned x;
    volatile LAS unsigned* st;
};

__device__ __forceinline__ XcdBarrier xcd_barrier_post(unsigned* bar, volatile LAS unsigned* st) {
    XcdBarrier b; b.bar = bar; b.x = xb_xcc_id(); b.st = st;
    if (threadIdx.x == 0) (void)xb_add(&bar[XB_XCNT(b.x)], 1u);
    return b;
}
__device__ __forceinline__ void xcd_barrier_complete(unsigned* bar, unsigned x, unsigned& nloc, unsigned& nx) {
    const unsigned G = gridDim.x * gridDim.y * gridDim.z;
    unsigned sum, cnt, mine, sp = 0u;
    for (;;) {
        sum = 0u; cnt = 0u; mine = 0u;
#pragma unroll
        for (unsigned j = 0; j < 16; ++j) { const unsigned c = xb_ld(&bar[XB_XCNT(j)]); sum += c; cnt += (c > 0u) ? 1u : 0u; mine = (j == x) ? c : mine; }
        if (sum == G) break;
        __builtin_amdgcn_s_sleep(1);
        if ((++sp & 255u) == 0u) { if (xb_ld(&bar[XB_TMO])) break; if (sp > XB_SPIN_CAP) { atomicAdd(&bar[XB_TMO], 1u); break; } }
    }
    nloc = mine > 0u ? mine : 1u; nx = cnt > 0u ? cnt : 1u;
}

__device__ __forceinline__ void xcd_barrier(const XcdBarrier& b) {
    asm volatile("s_waitcnt vmcnt(0)" ::: "memory");
    __syncthreads();
    if (threadIdx.x == 0) {
        unsigned* bar = b.bar;
        __builtin_amdgcn_s_waitcnt(0);
        unsigned nloc = b.st[0], nx = b.st[1];
        if (nloc == 0u) { xcd_barrier_complete(bar, b.x, nloc, nx); b.st[0] = nloc; b.st[1] = nx; }
        const unsigned old = xb_add(&bar[XB_XSUB(b.x)], 1u);
        const unsigned gen = old / nloc;
        if (old + 1u == (gen + 1u) * nloc) {
            __builtin_amdgcn_fence(__ATOMIC_RELEASE, "agent");
            asm volatile("s_waitcnt vmcnt(0)" ::: "memory");
            const unsigned og = xb_add(&bar[XB_TOP], 1u);
            const unsigned tg = og / nx;
            if (og + 1u == (tg + 1u) * nx) xb_add(&bar[XB_TOPGEN], 1u);
            else XB_SPIN(xb_ld(&bar[XB_TOPGEN]) == tg, bar);
            __builtin_amdgcn_fence(__ATOMIC_ACQUIRE, "agent");
            xb_add(&bar[XB_XGEN(b.x)], 1u);
            asm volatile("s_waitcnt vmcnt(0)" ::: "memory");
        } else {
            XB_SPIN(xb_ld(&bar[XB_XGEN(b.x)]) == gen, bar);
            __builtin_amdgcn_fence(__ATOMIC_ACQUIRE, "agent");
            asm volatile("s_waitcnt vmcnt(0)" ::: "memory");
        }
    }
    __syncthreads();
}

__device__ __forceinline__ void transpose_item(const float* W, int K, int N, bf16_t* WT, int ilv, int add, LAS float* scr, int item, int lane) {
    const int nblk = N / 32, kb = item / nblk, nb = item % nblk, k0 = 64 * kb, n0 = 32 * nb;
#pragma unroll
    for (int i = 0; i < 8; ++i) { const int kk = 8 * i + (lane >> 3), n4 = (lane & 7) * 4; const f32x4 v = __builtin_nontemporal_load((const f32x4*)(W + (size_t)(k0 + kk) * N + n0 + n4));
        LAS float* d = scr + kk * 33 + n4; d[0] = v.x; d[1] = v.y; d[2] = v.z; d[3] = v.w; }
    asm volatile("s_waitcnt lgkmcnt(0)" ::: "memory");
    const int c = lane & 7;
#pragma unroll
    for (int j = 0; j < 4; ++j) { const int nl = (lane >> 3) + 8 * j; const LAS float* s = scr + (8 * c) * 33 + nl;
        u32x4 o; o.x = pk2(s[0 * 33], s[1 * 33]); o.y = pk2(s[2 * 33], s[3 * 33]); o.z = pk2(s[4 * 33], s[5 * 33]); o.w = pk2(s[6 * 33], s[7 * 33]);
        const int n = n0 + nl; const int row = ilv ? (((n >> 7) << 8) + (n & 127) + add) : n;
        *(u32x4*)(WT + (size_t)row * K + k0 + 8 * c) = o; }
    asm volatile("s_waitcnt lgkmcnt(0)" ::: "memory");
}
__device__ __forceinline__ void convert_weights(const Args& a, int L, LAS unsigned char* lds, int gw, int NGW, int wave, int lane) {
    LAS float* scr = (LAS float*)(lds + wave * 16384);
    const int j = L >> 1; const bool nsa = (L & 1) != 0;
    const int NIN = nsa ? NSA_N : SWA_N;
    const float* w_in = nsa ? a.in[7] + (size_t)j * DM * NSA_N : a.in[2] + (size_t)j * DM * SWA_N;
    const float* w_o = nsa ? a.in[13] + (size_t)j * DM * DM : a.in[5] + (size_t)j * DM * DM;
    const float* w_g = a.in[14] + (size_t)L * DM * DFF; const float* w_u = a.in[15] + (size_t)L * DM * DFF; const float* w_d = a.in[18] + (size_t)L * DFF * DM;
    const float* w_c = a.in[9] + (size_t)j * 2 * DM * 512;
    bf16_t* WIN = (bf16_t*)(a.ws + WS_WIN); bf16_t* WO = (bf16_t*)(a.ws + WS_WO); bf16_t* WGU = (bf16_t*)(a.ws + WS_WGU); bf16_t* WDN = (bf16_t*)(a.ws + WS_WDN); bf16_t* WC1 = (bf16_t*)(a.ws + WS_WC1);
    const int I0 = 32 * (NIN / 32), I1 = 32 * 64, I2 = 32 * (DFF / 32), I4 = (DFF / 64) * 64, I5 = nsa ? 32 * 16 : 0;
    const int total = I0 + I1 + 2 * I2 + I4 + 2 * I5;
    for (int it = gw; it < total; it += NGW) {
        int r = it;
        if (r < I0) { transpose_item(w_in, DM, NIN, WIN, 0, 0, scr, r, lane); continue; } r -= I0;
        if (r < I1) { transpose_item(w_o, DM, DM, WO, 0, 0, scr, r, lane); continue; } r -= I1;
        if (r < I2) { transpose_item(w_g, DM, DFF, WGU, 1, 0, scr, r, lane); continue; } r -= I2;
        if (r < I2) { transpose_item(w_u, DM, DFF, WGU, 1, 128, scr, r, lane); continue; } r -= I2;
        if (r < I4) { transpose_item(w_d, DFF, DM, WDN, 0, 0, scr, r, lane); continue; } r -= I4;
        if (r < I5) { transpose_item(w_c, DM, 512, WC1, 0, 0, scr, r, lane); continue; } r -= I5;
        transpose_item(w_c + (size_t)DM * 512, DM, 512, WC1 + (size_t)512 * DM, 0, 0, scr, r, lane);
    }
}

__device__ __forceinline__ void row_phase(const bf16_t* mix, const float* xsrc, float* xdst, const float* gA, const float* gB, bf16_t* H, int gw, int NGW, int lane) {
    f32x4 ga[8], gb[8];
#pragma unroll
    for (int j = 0; j < 8; ++j) { ga[j] = mix ? ((const f32x4*)gA)[lane + 64 * j] : (f32x4){0.f, 0.f, 0.f, 0.f}; gb[j] = gB ? ((const f32x4*)gB)[lane + 64 * j] : (f32x4){0.f, 0.f, 0.f, 0.f}; }
    for (int row = gw; row < MTOK; row += NGW) {
        const f32x4* xr = (const f32x4*)(xsrc + (size_t)row * DM) + lane;
        f32x4 xv[8];
#pragma unroll
        for (int j = 0; j < 8; ++j) xv[j] = __builtin_nontemporal_load(&xr[64 * j]);
        if (mix) {
            const u32x2* mr = (const u32x2*)(mix + (size_t)row * DM) + lane;
            f32x4 mv[8]; float ss = 0.f;
#pragma unroll
            for (int j = 0; j < 8; ++j) { const u32x2 mb = __builtin_nontemporal_load(&mr[64 * j]); mv[j] = (f32x4){bflo(mb.x), bfhi(mb.x), bflo(mb.y), bfhi(mb.y)}; ss += (mv[j].x * mv[j].x + mv[j].y * mv[j].y) + (mv[j].z * mv[j].z + mv[j].w * mv[j].w); }
            const float r1 = 1.0f / sqrtf(wave_sum(ss) * (1.0f / DM) + RMS_EPS);
            f32x4* xo = (f32x4*)(xdst + (size_t)row * DM) + lane;
#pragma unroll
            for (int j = 0; j < 8; ++j) { const f32x4 g = ga[j]; xv[j] = xv[j] + mv[j] * r1 * g; __builtin_nontemporal_store(xv[j], &xo[64 * j]); }
        }
        if (gB) {
            float ss = 0.f;
#pragma unroll
            for (int j = 0; j < 8; ++j) ss += (xv[j].x * xv[j].x + xv[j].y * xv[j].y) + (xv[j].z * xv[j].z + xv[j].w * xv[j].w);
            const float r2 = 1.0f / sqrtf(wave_sum(ss) * (1.0f / DM) + RMS_EPS);
            u32x2* ho = (u32x2*)(H + (size_t)row * DM) + lane;
#pragma unroll
            for (int j = 0; j < 8; ++j) { const f32x4 g = gb[j]; const f32x4 h = xv[j] * r2 * g; u32x2 o; o.x = pk2(h.x, h.y); o.y = pk2(h.z, h.w); ho[64 * j] = o; }
        }
    }
}

__device__ __forceinline__ void act_phase(const bf16_t* GU, bf16_t* ACT, const float* cw, const float* cb, int gtid, int nthreads) {
    constexpr int NFC = DFF / 8, NRB = MTOK / 16;
    for (int it = gtid; it < NFC * NRB; it += nthreads) {
        const int fc = it % NFC, rb = it / NFC, f0 = fc * 8, r0 = rb * 16;
        const int gcol = ((f0 >> 7) << 8) + (f0 & 127);
        float w0[8], w1[8], w2[8], bb[8];
#pragma unroll
        for (int e = 0; e < 8; ++e) { w0[e] = cw[f0 + e]; w1[e] = cw[DFF + f0 + e]; w2[e] = cw[2 * DFF + f0 + e]; bb[e] = cb[f0 + e]; }
        float g2[8], g1[8];
        const bool has_prev = (r0 & (SEQ - 1)) != 0;
        {
            u32x4 a2 = (u32x4){0, 0, 0, 0}, a1 = (u32x4){0, 0, 0, 0};
            if (has_prev) { a2 = *(const u32x4*)(GU + (size_t)(r0 - 2) * GU_N + gcol); a1 = *(const u32x4*)(GU + (size_t)(r0 - 1) * GU_N + gcol); }
            g2[0] = bflo(a2.x); g2[1] = bfhi(a2.x); g2[2] = bflo(a2.y); g2[3] = bfhi(a2.y); g2[4] = bflo(a2.z); g2[5] = bfhi(a2.z); g2[6] = bflo(a2.w); g2[7] = bfhi(a2.w);
            g1[0] = bflo(a1.x); g1[1] = bfhi(a1.x); g1[2] = bflo(a1.y); g1[3] = bfhi(a1.y); g1[4] = bflo(a1.z); g1[5] = bfhi(a1.z); g1[6] = bflo(a1.w); g1[7] = bfhi(a1.w);
        }
#pragma unroll 4
        for (int i = 0; i < 16; ++i) {
            const u32x4 gv = *(const u32x4*)(GU + (size_t)(r0 + i) * GU_N + gcol);
            const u32x4 uv = *(const u32x4*)(GU + (size_t)(r0 + i) * GU_N + gcol + 128);
            float g0[8], up[8], o[8];
            g0[0] = bflo(gv.x); g0[1] = bfhi(gv.x); g0[2] = bflo(gv.y); g0[3] = bfhi(gv.y); g0[4] = bflo(gv.z); g0[5] = bfhi(gv.z); g0[6] = bflo(gv.w); g0[7] = bfhi(gv.w);
            up[0] = bflo(uv.x); up[1] = bfhi(uv.x); up[2] = bflo(uv.y); up[3] = bfhi(uv.y); up[4] = bflo(uv.z); up[5] = bfhi(uv.z); up[6] = bflo(uv.w); up[7] = bfhi(uv.w);
#pragma unroll
            for (int e = 0; e < 8; ++e) { const float av = bb[e] + w0[e] * g2[e] + w1[e] * g1[e] + w2[e] * g0[e];
                o[e] = av * __builtin_amdgcn_rcpf(1.0f + __builtin_amdgcn_exp2f(-LOG2E * av)) * up[e]; g2[e] = g1[e]; g1[e] = g0[e]; }
            u32x4 ov; ov.x = pk2(o[0], o[1]); ov.y = pk2(o[2], o[3]); ov.z = pk2(o[4], o[5]); ov.w = pk2(o[6], o[7]);
            *(u32x4*)(ACT + (size_t)(r0 + i) * DFF + f0) = ov;
        }
    }
}


__device__ __forceinline__ void act_fixup(const bf16_t* SBG0, const bf16_t* SBU0, const bf16_t* SBG1, bf16_t* ACT, const float* cw, const float* cb, int gtid, int nthreads) {
    constexpr int NFC = DFF / 8, NGRP = MTOK / 64;
    for (int it = gtid; it < NFC * NGRP * 2; it += nthreads) {
        const int fc = it % NFC, gr = it / NFC, r = gr & 1, grp = gr >> 1, f0 = fc * 8;
        const bool has_prev = (grp % (SEQ / 64)) != 0;
        const u32x4 z = (u32x4){0, 0, 0, 0};
        const u32x4 own0 = *(const u32x4*)(SBG0 + (size_t)(grp * 2 + 0) * DFF + f0), own1 = *(const u32x4*)(SBG0 + (size_t)(grp * 2 + 1) * DFF + f0);
        const u32x4 upv = *(const u32x4*)(SBU0 + (size_t)(grp * 2 + r) * DFF + f0);
        const u32x4 p62 = has_prev ? *(const u32x4*)(SBG1 + (size_t)((grp - 1) * 2 + 0) * DFF + f0) : z, p63 = has_prev ? *(const u32x4*)(SBG1 + (size_t)((grp - 1) * 2 + 1) * DFF + f0) : z;
        const u32x4 a2 = r ? p63 : p62, a1 = r ? own0 : p63, a0 = r ? own1 : own0;
        float g2[8], g1[8], g0[8], up[8], o[8];
        g2[0] = bflo(a2.x); g2[1] = bfhi(a2.x); g2[2] = bflo(a2.y); g2[3] = bfhi(a2.y); g2[4] = bflo(a2.z); g2[5] = bfhi(a2.z); g2[6] = bflo(a2.w); g2[7] = bfhi(a2.w);
        g1[0] = bflo(a1.x); g1[1] = bfhi(a1.x); g1[2] = bflo(a1.y); g1[3] = bfhi(a1.y); g1[4] = bflo(a1.z); g1[5] = bfhi(a1.z); g1[6] = bflo(a1.w); g1[7] = bfhi(a1.w);
        g0[0] = bflo(a0.x); g0[1] = bfhi(a0.x); g0[2] = bflo(a0.y); g0[3] = bfhi(a0.y); g0[4] = bflo(a0.z); g0[5] = bfhi(a0.z); g0[6] = bflo(a0.w); g0[7] = bfhi(a0.w);
        up[0] = bflo(upv.x); up[1] = bfhi(upv.x); up[2] = bflo(upv.y); up[3] = bfhi(upv.y); up[4] = bflo(upv.z); up[5] = bfhi(upv.z); up[6] = bflo(upv.w); up[7] = bfhi(upv.w);
#pragma unroll
        for (int e = 0; e < 8; ++e) { const float av = cb[f0 + e] + cw[f0 + e] * g2[e] + cw[DFF + f0 + e] * g1[e] + cw[2 * DFF + f0 + e] * g0[e];
            o[e] = av * __builtin_amdgcn_rcpf(1.0f + __builtin_amdgcn_exp2f(-LOG2E * av)) * up[e]; }
        u32x4 ov; ov.x = pk2(o[0], o[1]); ov.y = pk2(o[2], o[3]); ov.z = pk2(o[4], o[5]); ov.w = pk2(o[6], o[7]);
        *(u32x4*)(ACT + (size_t)(grp * 64 + r) * DFF + f0) = ov;
    }
}
__device__ __forceinline__ void cmp_build(const bf16_t* PROJ, const float* pe  , bf16_t* ACMP, int gtid, int nthreads) {
    for (int it = gtid; it < 2 * CMP_ROWS * 256; it += nthreads) {
        const int piece = it & 255, row = (it >> 8) & (CMP_ROWS - 1), kv = it >> 20;
        u32x4 o = (u32x4){0, 0, 0, 0};
        if (row < NBATCH * NCMP * 4) {
            const int g = row & 3, bn = row >> 2, n = bn % NCMP, b = bn / NCMP, l = piece >> 3, d0 = (piece & 7) * 8;
            const u32x4 s = *(const u32x4*)(PROJ + (size_t)(b * SEQ + 16 * n + l) * NSA_LD + 2048 + kv * 256 + g * 64 + d0);
            const float* p = pe + (kv * 32 + l) * 64 + d0;
            o.x = pk2(bflo(s.x) + p[0], bfhi(s.x) + p[1]); o.y = pk2(bflo(s.y) + p[2], bfhi(s.y) + p[3]);
            o.z = pk2(bflo(s.z) + p[4], bfhi(s.z) + p[5]); o.w = pk2(bflo(s.w) + p[6], bfhi(s.w) + p[7]);
        }
        *(u32x4*)(ACMP + ((size_t)kv * CMP_ROWS + row) * 2048 + piece * 8) = o;
    }
}
__device__ __forceinline__ void cmp_out(const bf16_t* HID, const float* w2  , const float* b2  , bf16_t* KVC, LAS unsigned char* lds, int tid, int gw, int NGW) {
    LAS float* wl = (LAS float*)lds;
    const int lane = tid & 63;
    for (int kv = 0; kv < 2; ++kv) {
        __syncthreads();
        for (int i = tid; i < 512 * 64 / 4; i += 512) ((LAS f32x4*)wl)[i] = ((const f32x4*)(w2 + (size_t)kv * 512 * 64))[i];
        __syncthreads();
        const float bias = b2[kv * 64 + lane];
        for (int r = gw; r < 2 * 4 * 512; r += NGW) {
            const int n = r & 511, g = (r >> 9) & 3, b = r >> 11;
            float acc = 0.f;
            if (n < NCMP) {
                const int row = (b * NCMP + n) * 4 + g;
                const u32x4* hp = (const u32x4*)(HID + ((size_t)kv * CMP_ROWS + row) * 512);
                float a0 = bias, a1 = 0.f, a2 = 0.f, a3 = 0.f;
#pragma unroll 4
                for (int c8 = 0; c8 < 64; ++c8) { const u32x4 h = hp[c8]; const LAS float* w = wl + c8 * 8 * 64 + lane;
                    a0 += bflo(h.x) * w[0] + bfhi(h.x) * w[64]; a1 += bflo(h.y) * w[128] + bfhi(h.y) * w[192]; a2 += bflo(h.z) * w[256] + bfhi(h.z) * w[320]; a3 += bflo(h.w) * w[384] + bfhi(h.w) * w[448]; }
                acc = (a0 + a1) + (a2 + a3);
            }
            KVC[((size_t)kv * 4096 + r) * 64 + lane] = (bf16_t)(pk2(acc, 0.f) & 0xffffu);
        }
    }
    __syncthreads();
}

constexpr float MFLOOR = -3.0e4f;

__device__ __forceinline__ float xmax16(float v) { auto r = __builtin_amdgcn_permlane16_swap(__float_as_uint(v), __float_as_uint(v), false, false); return fmaxf(__uint_as_float(r[0]), __uint_as_float(r[1])); }
__device__ __forceinline__ float xmax32(float v) { auto r = __builtin_amdgcn_permlane32_swap(__float_as_uint(v), __float_as_uint(v), false, false); return fmaxf(__uint_as_float(r[0]), __uint_as_float(r[1])); }
__device__ __forceinline__ float xsum16(float v) { auto r = __builtin_amdgcn_permlane16_swap(__float_as_uint(v), __float_as_uint(v), false, false); return __uint_as_float(r[0]) + __uint_as_float(r[1]); }
__device__ __forceinline__ float xsum32(float v) { auto r = __builtin_amdgcn_permlane32_swap(__float_as_uint(v), __float_as_uint(v), false, false); return __uint_as_float(r[0]) + __uint_as_float(r[1]); }
template <int CTRL> __device__ __forceinline__ float dppf(float v) { return __int_as_float(__builtin_amdgcn_update_dpp(0, __float_as_int(v), CTRL, 0xF, 0xF, true)); }
template <int CTRL> __device__ __forceinline__ int dppi(int v) { return __builtin_amdgcn_update_dpp(0, v, CTRL, 0xF, 0xF, true); }
constexpr int DPP_X1 = 0xB1  , DPP_X2 = 0x4E  , DPP_HM = 0x141  , DPP_RM = 0x140  ;
constexpr int NQT = 2, UQ = 16 * NQT, NUNIT = MTOK * 4 / UQ, QBN = SEQ / UQ;
template <int MODE, int KSTRIDE, bool MASKED = true, bool SEL = false>
__device__ __forceinline__ void chunk_compute(LAS const unsigned char* Ks, LAS const unsigned char* Vt, const bf16x8 (&qf)[NQT][2], float (&m)[NQT], float (&l)[NQT], f32x4 (&O)[NQT][4], f32x4 (&L)[NQT], const bf16x8 onesf,
                                              int tq0, float sl2, int kp0, int W, unsigned selbits, int c, int quad,
                                              volatile LAS float* imp_rows, int jb0, const float (&linv)[NQT]) {
    int dbase = tq0 - kp0 - quad * 4 * KSTRIDE;
    asm volatile("" : "+v"(dbase));
    bf16x8 kf[4][2];
#pragma unroll
    for (int kt = 0; kt < 4; ++kt)
#pragma unroll
        for (int ks = 0; ks < 2; ++ks) kf[kt][ks] = *(LAS const bf16x8*)(Ks + ((kt * 16 + c) * ROWE + ks * 32 + quad * 8) * 2);
    bf16x8 pb[NQT][2]; bool act[NQT];
#pragma unroll
    for (int qt = 0; qt < NQT; ++qt) {
        const bool selq = ((selbits >> qt) & 1u) != 0u;
        act[qt] = SEL ? (__any(selq ? 1 : 0) != 0) : true;
        pb[qt][0] = (bf16x8){0, 0, 0, 0, 0, 0, 0, 0}; pb[qt][1] = pb[qt][0];
        if (!act[qt]) continue;
        f32x4 s[4];
        const int dq = dbase + 2 * qt; const float bbq = (MASKED || selq) ? -sl2 * (float)dq : -1e30f;
#pragma unroll
        for (int kt = 0; kt < 4; ++kt) {
            s[kt] = (f32x4){__builtin_fmaf(sl2, (float)((kt * 16 + 0) * KSTRIDE), bbq), __builtin_fmaf(sl2, (float)((kt * 16 + 1) * KSTRIDE), bbq), __builtin_fmaf(sl2, (float)((kt * 16 + 2) * KSTRIDE), bbq), __builtin_fmaf(sl2, (float)((kt * 16 + 3) * KSTRIDE), bbq)};
#pragma unroll
            for (int ks = 0; ks < 2; ++ks) s[kt] = __builtin_amdgcn_mfma_f32_16x16x32_bf16(kf[kt][ks], qf[qt][ks], s[kt], 0, 0, 0);
        }
        float mx = -1e30f;
        const int tqq = tq0 + 2 * qt;
        const unsigned lim = selq ? (unsigned)(W < tqq + 1 ? W : tqq + 1) : 0u;
#pragma unroll
        for (int kt = 0; kt < 4; ++kt)
#pragma unroll
            for (int j = 0; j < 4; ++j) {
                const int C = (kt * 16 + j) * KSTRIDE;
                float v = s[kt][j];
                if (MASKED) { const bool valid = (unsigned)(dq - C) < lim; v = valid ? v : -1e30f; }
                s[kt][j] = v; mx = fmaxf(mx, v);
            }
        if (MODE != 2) {
            mx = xmax32(xmax16(mx));
            const float mnew = fmaxf(m[qt], mx); const float alpha = __builtin_amdgcn_exp2f(m[qt] - mnew); m[qt] = mnew;
            float psum = 0.f;
#pragma unroll
            for (int kt = 0; kt < 4; ++kt)
#pragma unroll
                for (int j = 0; j < 4; ++j) { const float p = __builtin_amdgcn_exp2f(s[kt][j] - mnew); s[kt][j] = p; psum += p; }
            if (MODE == 1) l[qt] = l[qt] * alpha + psum;
            if (MODE == 0) {
                L[qt] = L[qt] * alpha;
#pragma unroll
                for (int dt = 0; dt < 4; ++dt) O[qt][dt] = O[qt][dt] * alpha;
            }
        } else {
#pragma unroll
            for (int kt = 0; kt < 4; ++kt)
#pragma unroll
                for (int j = 0; j < 4; ++j) { const float p = __builtin_amdgcn_exp2f(s[kt][j] - m[qt]) * linv[qt]; s[kt][j] = p; }
#pragma unroll
            for (int kt = 0; kt < 4; ++kt) {
                f32x4 hs = s[kt];
#pragma unroll
                for (int j = 0; j < 4; ++j) { hs[j] += dppf<DPP_X1>(hs[j]); hs[j] += dppf<DPP_X2>(hs[j]); hs[j] += dppf<DPP_HM>(hs[j]); }
                if ((c & 7) == 0) {
                    const int ql = qt * 2 + (c >> 3); const int jb = jb0 + kt * 4 + quad;
                    LAS float* p0 = (LAS float*)imp_rows + ql * 128 + jb;
                    (void)__hip_atomic_fetch_add(p0, (hs[0] + hs[1]) + (hs[2] + hs[3]), __ATOMIC_RELAXED, __HIP_MEMORY_SCOPE_WORKGROUP);
                    if (jb + 1 < 128) (void)__hip_atomic_fetch_add(p0 + 1, hs[3], __ATOMIC_RELAXED, __HIP_MEMORY_SCOPE_WORKGROUP);
                }
            }
        }
        if (MODE != 1) {
#pragma unroll
            for (int i = 0; i < 2; ++i) {
                u32x4 w; w.x = pk2(s[2 * i][0], s[2 * i][1]); w.y = pk2(s[2 * i][2], s[2 * i][3]); w.z = pk2(s[2 * i + 1][0], s[2 * i + 1][1]); w.w = pk2(s[2 * i + 1][2], s[2 * i + 1][3]);
                pb[qt][i] = __builtin_bit_cast(bf16x8, w);
            }
        }
    }
    if (MODE != 1) {
        bf16x8 vf[4][2];
#pragma unroll
        for (int dt = 0; dt < 4; ++dt)
#pragma unroll
            for (int i = 0; i < 2; ++i) {
                vf[dt][i] = *(LAS const bf16x8*)(Vt + ((dt * 16 + c) * ROWE + ((32 * i + quad * 8) ^ (dt * 16))) * 2);
            }
#pragma unroll
        for (int qt = 0; qt < NQT; ++qt) {
            if (!act[qt]) continue;
#pragma unroll
            for (int dt = 0; dt < 4; ++dt)
#pragma unroll
                for (int i = 0; i < 2; ++i) O[qt][dt] = __builtin_amdgcn_mfma_f32_16x16x32_bf16(vf[dt][i], pb[qt][i], O[qt][dt], 0, 0, 0);
            if (MODE == 0) {
#pragma unroll
                for (int i = 0; i < 2; ++i) L[qt] = __builtin_amdgcn_mfma_f32_16x16x32_bf16(onesf, pb[qt][i], L[qt], 0, 0, 0);
            }
        }
    }
}

__device__ __forceinline__ bf16x8 scale_q(bf16x8 q) {
    const u32x4 u = __builtin_bit_cast(u32x4, q); u32x4 o;
    o.x = pk2(bflo(u.x) * QSC, bfhi(u.x) * QSC); o.y = pk2(bflo(u.y) * QSC, bfhi(u.y) * QSC); o.z = pk2(bflo(u.z) * QSC, bfhi(u.z) * QSC); o.w = pk2(bflo(u.w) * QSC, bfhi(u.w) * QSC);
    return __builtin_bit_cast(bf16x8, o);
}
#define STG_LOAD(kp_, vp_, ld_, row_) do { const int rr_ = (row_) + (tid >> 3); if (rr_ >= 0 && rr_ < SEQ) { kreg = *(const u32x4*)((kp_) + (size_t)rr_ * (ld_) + (tid & 7) * 8); vreg = *(const u32x4*)((vp_) + (size_t)rr_ * (ld_) + (tid & 7) * 8); } \
        else { kreg = (u32x4){0, 0, 0, 0}; vreg = (u32x4){0, 0, 0, 0}; } } while (0)
#define STG_STORE(buf_) do { *(LAS u32x4*)(lds + KS_OFF + (buf_) * KS_BYTES + (tid >> 3) * (ROWE * 2) + (tid & 7) * 16) = kreg; \
        const int key_ = tid >> 3, pos_ = ((key_ & ~31) + ((key_ >> 2) & 3) * 8 + ((key_ >> 4) & 1) * 4 + (key_ & 3)) ^ (((tid & 7) >> 1) << 4);         \
        LAS bf16_t* vt_ = (LAS bf16_t*)(lds + VT_OFF + (buf_) * VT_BYTES) + ((tid & 7) * 8) * ROWE + pos_; \
        vt_[0 * ROWE] = (bf16_t)(vreg.x & 0xffffu); vt_[1 * ROWE] = (bf16_t)(vreg.x >> 16); vt_[2 * ROWE] = (bf16_t)(vreg.y & 0xffffu); vt_[3 * ROWE] = (bf16_t)(vreg.y >> 16); \
        vt_[4 * ROWE] = (bf16_t)(vreg.z & 0xffffu); vt_[5 * ROWE] = (bf16_t)(vreg.z >> 16); vt_[6 * ROWE] = (bf16_t)(vreg.w & 0xffffu); vt_[7 * ROWE] = (bf16_t)(vreg.w >> 16); } while (0)
#define KSBUF(b_) ((LAS const unsigned char*)(lds + KS_OFF + (b_) * KS_BYTES))
#define VTBUF(b_) ((LAS const unsigned char*)(lds + VT_OFF + (b_) * VT_BYTES))

__device__ __forceinline__ void swa_unit(const bf16_t* PROJ, const float* sinks, bf16_t* Obuf, int unit, LAS unsigned char* lds, const int tid) {
    const int lane = tid & 63, w = tid >> 6, c = lane & 15, quad = lane >> 4;
    const int qb = unit % QBN, kvh = (unit / QBN) & 3, b = unit / (4 * QBN), t0 = qb * UQ;
    const int head = kvh * 8 + (c & 7);
    const float sl2 = __builtin_amdgcn_exp2f(-0.25f * (float)(head + 1)) * LOG2E;
    const bf16_t* base = PROJ + (size_t)b * SEQ * SWA_N;
    const bf16_t* kp = base + 2048 + kvh * 64; const bf16_t* vp = base + 2304 + kvh * 64;
    bf16x8 qf[NQT][2]; float m[NQT], l[NQT], linv[NQT]; f32x4 O[NQT][4]; f32x4 L[NQT];
    const bf16x8 onesf = (c == 0) ? (bf16x8){0x3F80, 0x3F80, 0x3F80, 0x3F80, 0x3F80, 0x3F80, 0x3F80, 0x3F80} : (bf16x8){0, 0, 0, 0, 0, 0, 0, 0};
    const int tq0 = t0 + 2 * NQT * w + (c >> 3);
    const float sink2 = sinks[head] * LOG2E;
#pragma unroll
    for (int qt = 0; qt < NQT; ++qt) {
        m[qt] = sink2; l[qt] = 0.f; linv[qt] = 0.f; L[qt] = (f32x4){(quad == 0) ? 1.0f : 0.0f, 0.f, 0.f, 0.f};
#pragma unroll
        for (int ks = 0; ks < 2; ++ks) qf[qt][ks] = scale_q(__builtin_nontemporal_load((const bf16x8*)(base + (size_t)(tq0 + 2 * qt) * SWA_N + head * 64 + ks * 32 + quad * 8)));
#pragma unroll
        for (int dt = 0; dt < 4; ++dt) O[qt][dt] = (f32x4){0.f, 0.f, 0.f, 0.f};
    }
    u32x4 kreg, vreg;
    STG_LOAD(kp, vp, SWA_N, t0 - 128); STG_STORE(0); __syncthreads();
    for (int ci = 0; ci < 3; ++ci) {
        if (ci + 1 < 3) STG_LOAD(kp, vp, SWA_N, t0 - 128 + 64 * (ci + 1));
        chunk_compute<0, 1>(KSBUF(ci & 1), VTBUF(ci & 1), qf, m, l, O, L, onesf, tq0, sl2, t0 - 128 + 64 * ci, 128, 0xFu, c, quad, nullptr, 0, linv);
        if (ci + 1 < 3) STG_STORE((ci + 1) & 1);
        __syncthreads();
    }
#pragma unroll
    for (int qt = 0; qt < NQT; ++qt) {
        float lt = L[qt][0]; lt = xsum32(xsum16(lt));
        const float inv = 1.0f / lt;
        bf16_t* orow = Obuf + (size_t)(b * SEQ + (tq0 + 2 * qt)) * DM + head * 64 + quad * 4;
#pragma unroll
        for (int dt = 0; dt < 4; ++dt) { const f32x4 o = O[qt][dt] * inv; u32x2 pk; pk.x = pk2(o[0], o[1]); pk.y = pk2(o[2], o[3]); *(u32x2*)(orow + dt * 16) = pk; }
    }
}

#define GATE(qt_, i_) __builtin_amdgcn_rcpf(1.0f + __builtin_amdgcn_exp2f(-LOG2E * gatev[qt_][i_]))
__device__ __forceinline__ void nsa_unit(const bf16_t* PROJ, const bf16_t* KVC, float* OACC, bf16_t* Obuf, int unit, LAS unsigned char* lds, const int tid) {
    const int lane = tid & 63, w = tid >> 6, c = lane & 15, quad = lane >> 4;
    const int qb = unit % QBN, g = (unit / QBN) & 3, b = unit / (4 * QBN), t0 = qb * UQ;
    const int head = g * 8 + (c & 7);
    const float sl2 = __builtin_amdgcn_exp2f(-0.25f * (float)(head + 1)) * LOG2E;
    const bf16_t* base = PROJ + (size_t)b * SEQ * NSA_LD;
    volatile LAS float* imp_rows = (volatile LAS float*)(lds + IMP_OFF) + (2 * NQT * w) * 128;
    volatile LAS unsigned* selm = (volatile LAS unsigned*)(lds + SELM_OFF);
    volatile LAS unsigned* uni = (volatile LAS unsigned*)(lds + UNI_OFF);
    bf16x8 qf[NQT][2]; float m[NQT], l[NQT], linv[NQT]; f32x4 O[NQT][4]; f32x4 L[NQT];
    const bf16x8 onesf = (c == 0) ? (bf16x8){0x3F80, 0x3F80, 0x3F80, 0x3F80, 0x3F80, 0x3F80, 0x3F80, 0x3F80} : (bf16x8){0, 0, 0, 0, 0, 0, 0, 0};
    const int tq0 = t0 + 2 * NQT * w + (c >> 3);
#pragma unroll
    for (int qt = 0; qt < NQT; ++qt) {
        const bf16_t* prow = base + (size_t)(tq0 + 2 * qt) * NSA_LD;
#pragma unroll
        for (int ks = 0; ks < 2; ++ks) qf[qt][ks] = scale_q(__builtin_nontemporal_load((const bf16x8*)(prow + head * 64 + ks * 32 + quad * 8)));
    }
    for (int i = lane; i < 2 * NQT * 128; i += 64) imp_rows[i] = 0.f;
    float gatev[NQT][3];
#pragma unroll
    for (int qt = 0; qt < NQT; ++qt)
#pragma unroll
        for (int i = 0; i < 3; ++i) gatev[qt][i] = bf2f(base[(size_t)(tq0 + 2 * qt) * NSA_LD + 3584 + head * 3 + i]);
    u32x4 kreg, vreg;
    const bf16_t* kc = KVC + ((size_t)((0 * 2 + b) * 4 + g) * 512) * 64; const bf16_t* vc = KVC + ((size_t)((1 * 2 + b) * 4 + g) * 512) * 64;
    const int nmax = (t0 + UQ - 1 - 31) >> 4, ncc = (nmax >> 6) + 1;
    const bf16_t* ksl = base + 2560 + g * 64; const bf16_t* vsl = base + 2816 + g * 64;
    const bf16_t* kwp = base + 3072 + g * 64; const bf16_t* vwp = base + 3328 + g * 64;
    const int c0 = (t0 >= 512) ? 0 : (512 - t0) / 64;
#pragma unroll
    for (int qt = 0; qt < NQT; ++qt) { m[qt] = MFLOOR; l[qt] = 0.f; linv[qt] = 0.f; L[qt] = (f32x4){0.f, 0.f, 0.f, 0.f}; }
    STG_LOAD(kc, vc, 64, 0); STG_STORE(0); __syncthreads();
    {
        const int nun = (t0 >= 1039) ? (t0 - 1039) / 1024 + 1 : 0;
        int ci = 0;
        for (; ci < nun; ++ci) {
            STG_LOAD(kc, vc, 64, 64 * (ci + 1));
            chunk_compute<1, 16, false>(KSBUF(ci & 1), VTBUF(ci & 1), qf, m, l, O, L, onesf, tq0, sl2, 16 * (64 * ci) + 31, 1 << 30, 0xFu, c, quad, imp_rows, 0, linv);
            STG_STORE((ci + 1) & 1);
            __syncthreads();
        }
        for (; ci < ncc; ++ci) {
            STG_LOAD(kc, vc, 64, (ci + 1 < ncc) ? 64 * (ci + 1) : 0);
            chunk_compute<1, 16, true>(KSBUF(ci & 1), VTBUF(ci & 1), qf, m, l, O, L, onesf, tq0, sl2, 16 * (64 * ci) + 31, 1 << 30, 0xFu, c, quad, imp_rows, 0, linv);
            STG_STORE((ci + 1) & 1);
            __syncthreads();
        }
    }
#pragma unroll
    for (int qt = 0; qt < NQT; ++qt) {
        float lt = l[qt]; lt = xsum32(xsum16(lt)); linv[qt] = lt > 0.f ? 1.0f / lt : 0.f;
#pragma unroll
        for (int dt = 0; dt < 4; ++dt) O[qt][dt] = (f32x4){0.f, 0.f, 0.f, 0.f};
    }
    {
        const int nun = (t0 >= 1039) ? (t0 - 1039) / 1024 + 1 : 0;
        const int pb = ncc & 1;
        int ci = 0;
        for (; ci < nun; ++ci) {
            STG_LOAD(kc, vc, 64, 64 * (ci + 1));
            chunk_compute<2, 16, false>(KSBUF((ci + pb) & 1), VTBUF((ci + pb) & 1), qf, m, l, O, L, onesf, tq0, sl2, 16 * (64 * ci) + 31, 1 << 30, 0xFu, c, quad, imp_rows, 16 * ci, linv);
            STG_STORE((ci + 1 + pb) & 1);
            __syncthreads();
        }
        for (; ci < ncc; ++ci) {
            if (ci + 1 < ncc) STG_LOAD(kc, vc, 64, 64 * (ci + 1)); else STG_LOAD(ksl, vsl, NSA_LD, 0);
            chunk_compute<2, 16, true>(KSBUF((ci + pb) & 1), VTBUF((ci + pb) & 1), qf, m, l, O, L, onesf, tq0, sl2, 16 * (64 * ci) + 31, 1 << 30, 0xFu, c, quad, imp_rows, 16 * ci, linv);
            STG_STORE((ci + 1 + pb) & 1);
            __syncthreads();
        }
    }
#pragma unroll
    for (int qt = 0; qt < NQT; ++qt) {
        LAS f32x4* ol = (LAS f32x4*)(lds + OACC_OFF) + ((w * NQT + qt) * 4) * 64 + lane;
#pragma unroll
        for (int dt = 0; dt < 4; ++dt) ol[dt * 64] = O[qt][dt] * GATE(qt, 0);
    }
    {
        const int ql = lane >> 4, sub = lane & 15; const int cur = (t0 + 4 * w + ql) >> 6;
        float v[8];
#pragma unroll
        for (int i = 0; i < 8; ++i) { const int jb = sub + 16 * i; const float x = imp_rows[ql * 128 + jb]; const bool forced = (jb == 0) || (jb == cur) || (jb == cur - 1); v[i] = forced ? -2.0f : (jb <= cur ? x : -1.0f); }
        unsigned mk0 = 1u, mk1 = 0u, mk2 = 0u, mk3 = 0u;
        { const int wd = cur >> 5; const unsigned bit = 1u << (cur & 31); mk0 |= (wd == 0) ? bit : 0u; mk1 |= (wd == 1) ? bit : 0u; mk2 |= (wd == 2) ? bit : 0u; mk3 |= (wd == 3) ? bit : 0u; }
        if (cur >= 1) { const int pj = cur - 1; const int wd = pj >> 5; const unsigned bit = 1u << (pj & 31); mk0 |= (wd == 0) ? bit : 0u; mk1 |= (wd == 1) ? bit : 0u; mk2 |= (wd == 2) ? bit : 0u; mk3 |= (wd == 3) ? bit : 0u; }
        const int nforced = (cur >= 2) ? 3 : cur + 1;
        for (int round = nforced; round < 16; ++round) {
            float bv = v[0]; int bi = sub;
#pragma unroll
            for (int i = 1; i < 8; ++i) if (v[i] > bv) { bv = v[i]; bi = sub + 16 * i; }
            { float ov = dppf<DPP_X1>(bv); int oi = dppi<DPP_X1>(bi); if (ov > bv || (ov == bv && oi < bi)) { bv = ov; bi = oi; }
              ov = dppf<DPP_X2>(bv); oi = dppi<DPP_X2>(bi); if (ov > bv || (ov == bv && oi < bi)) { bv = ov; bi = oi; }
              ov = dppf<DPP_HM>(bv); oi = dppi<DPP_HM>(bi); if (ov > bv || (ov == bv && oi < bi)) { bv = ov; bi = oi; }
              ov = dppf<DPP_RM>(bv); oi = dppi<DPP_RM>(bi); if (ov > bv || (ov == bv && oi < bi)) { bv = ov; bi = oi; } }
            if (!__any(bv >= 0.f ? 1 : 0)) break;
            if (bv >= 0.f) { const unsigned bit = 1u << (bi & 31); const int wd = bi >> 5; mk0 |= (wd == 0) ? bit : 0u; mk1 |= (wd == 1) ? bit : 0u; mk2 |= (wd == 2) ? bit : 0u; mk3 |= (wd == 3) ? bit : 0u;
#pragma unroll
                for (int i = 0; i < 8; ++i) if (bi == sub + 16 * i) v[i] = -2.0f; }
        }
        if (sub == 0) { selm[(4 * w + ql) * 4 + 0] = mk0; selm[(4 * w + ql) * 4 + 1] = mk1; selm[(4 * w + ql) * 4 + 2] = mk2; selm[(4 * w + ql) * 4 + 3] = mk3; }
        { unsigned u0 = mk0, u1 = mk1, u2 = mk2, u3 = mk3;
          { auto r = __builtin_amdgcn_permlane16_swap(u0, u0, false, false); u0 = r[0] | r[1]; } { auto r = __builtin_amdgcn_permlane32_swap(u0, u0, false, false); u0 = r[0] | r[1]; }
          { auto r = __builtin_amdgcn_permlane16_swap(u1, u1, false, false); u1 = r[0] | r[1]; } { auto r = __builtin_amdgcn_permlane32_swap(u1, u1, false, false); u1 = r[0] | r[1]; }
          { auto r = __builtin_amdgcn_permlane16_swap(u2, u2, false, false); u2 = r[0] | r[1]; } { auto r = __builtin_amdgcn_permlane32_swap(u2, u2, false, false); u2 = r[0] | r[1]; }
          { auto r = __builtin_amdgcn_permlane16_swap(u3, u3, false, false); u3 = r[0] | r[1]; } { auto r = __builtin_amdgcn_permlane32_swap(u3, u3, false, false); u3 = r[0] | r[1]; }
          if (lane == 0) { uni[16 + 4 * w + 0] = u0; uni[16 + 4 * w + 1] = u1; uni[16 + 4 * w + 2] = u2; uni[16 + 4 * w + 3] = u3; } }
    }
    __syncthreads();
    int wpb = 0;
    {
        unsigned uw0 = 0u, uw1 = 0u, uw2 = 0u, uw3 = 0u;
#pragma unroll
        for (int ww = 0; ww < 8; ++ww) { uw0 |= uni[16 + 4 * ww + 0]; uw1 |= uni[16 + 4 * ww + 1]; uw2 |= uni[16 + 4 * ww + 2]; uw3 |= uni[16 + 4 * ww + 3]; }
        unsigned long long um0 = ((unsigned long long)uw1 << 32) | uw0, um1 = ((unsigned long long)uw3 << 32) | uw2;
        { const int cmx = (t0 + UQ - 1) >> 6; if (cmx < 63) { um0 &= (2ull << cmx) - 1ull; um1 = 0ull; } else if (cmx == 63) { um1 = 0ull; } else if (cmx < 127) { um1 &= (2ull << (cmx - 64)) - 1ull; } }
        um0 = ((unsigned long long)__builtin_amdgcn_readfirstlane((unsigned)(um0 >> 32)) << 32) | (unsigned)__builtin_amdgcn_readfirstlane((unsigned)um0);
        um1 = ((unsigned long long)__builtin_amdgcn_readfirstlane((unsigned)(um1 >> 32)) << 32) | (unsigned)__builtin_amdgcn_readfirstlane((unsigned)um1);
#pragma unroll
        for (int qt = 0; qt < NQT; ++qt) { m[qt] = MFLOOR; l[qt] = 0.f; L[qt] = (f32x4){0.f, 0.f, 0.f, 0.f};
#pragma unroll
            for (int dt = 0; dt < 4; ++dt) O[qt][dt] = (f32x4){0.f, 0.f, 0.f, 0.f}; }
        int jb = 0; um0 &= ~1ull; int bufi = 0;
        for (;;) {
            int jn = -1;
            if (um0) { jn = __builtin_ctzll(um0); um0 &= um0 - 1ull; } else if (um1) { jn = 64 + __builtin_ctzll(um1); um1 &= um1 - 1ull; }
            if (jn < 0) break;
            STG_LOAD(ksl, vsl, NSA_LD, 64 * jn);
            unsigned selbits = 0u;
#pragma unroll
            for (int qt = 0; qt < NQT; ++qt) { const unsigned wv = selm[(2 * NQT * w + qt * 2 + (c >> 3)) * 4 + (jb >> 5)]; selbits |= ((wv >> (jb & 31)) & 1u) << qt; }
            chunk_compute<0, 1, false, true>(KSBUF(bufi), VTBUF(bufi), qf, m, l, O, L, onesf, tq0, sl2, 64 * jb, 1 << 30, selbits, c, quad, imp_rows, 0, linv);
            STG_STORE(bufi ^ 1);
            __syncthreads();
            jb = jn; bufi ^= 1;
        }
        {
            unsigned selbits = 0u;
#pragma unroll
            for (int qt = 0; qt < NQT; ++qt) { const unsigned wv = selm[(2 * NQT * w + qt * 2 + (c >> 3)) * 4 + (jb >> 5)]; selbits |= ((wv >> (jb & 31)) & 1u) << qt; }
            STG_LOAD(kwp, vwp, NSA_LD, t0 - 512 + 64 * c0);
            chunk_compute<0, 1, true, true>(KSBUF(bufi), VTBUF(bufi), qf, m, l, O, L, onesf, tq0, sl2, 64 * jb, 1 << 30, selbits, c, quad, imp_rows, 0, linv);
            STG_STORE(bufi ^ 1);
            __syncthreads();
        }
        wpb = bufi ^ 1;
#pragma unroll
        for (int qt = 0; qt < NQT; ++qt) {
            float lt = L[qt][0]; lt = xsum32(xsum16(lt)); const float sc = (lt > 0.f ? 1.0f / lt : 0.f) * GATE(qt, 1);
            LAS f32x4* ol = (LAS f32x4*)(lds + OACC_OFF) + ((w * NQT + qt) * 4) * 64 + lane;
#pragma unroll
            for (int dt = 0; dt < 4; ++dt) { const f32x4 prev = ol[dt * 64]; ol[dt * 64] = prev + O[qt][dt] * sc; }
        }
    }
    {
#pragma unroll
        for (int qt = 0; qt < NQT; ++qt) { m[qt] = MFLOOR; l[qt] = 0.f; L[qt] = (f32x4){0.f, 0.f, 0.f, 0.f};
#pragma unroll
            for (int dt = 0; dt < 4; ++dt) O[qt][dt] = (f32x4){0.f, 0.f, 0.f, 0.f}; }
#define WIN_ITER(MSK_) do { const int bsel = (ci - c0 + wpb) & 1; STG_LOAD(kwp, vwp, NSA_LD, t0 - 512 + 64 * (ci + 1)); \
            chunk_compute<0, 1, MSK_>(KSBUF(bsel), VTBUF(bsel), qf, m, l, O, L, onesf, tq0, sl2, t0 - 512 + 64 * ci, 512, 0xFu, c, quad, imp_rows, 0, linv); \
            STG_STORE(bsel ^ 1); __syncthreads(); } while (0)
        int ci = c0;
        if (ci < 8) { WIN_ITER(true); ++ci; }
        for (; ci < 8; ++ci) WIN_ITER(false);
#undef WIN_ITER
        chunk_compute<0, 1, true>(KSBUF((8 - c0 + wpb) & 1), VTBUF((8 - c0 + wpb) & 1), qf, m, l, O, L, onesf, tq0, sl2, t0, 512, 0xFu, c, quad, imp_rows, 0, linv);
        __syncthreads();
#pragma unroll
        for (int qt = 0; qt < NQT; ++qt) {
            float lt = L[qt][0]; lt = xsum32(xsum16(lt)); const float sc = (lt > 0.f ? 1.0f / lt : 0.f) * GATE(qt, 2);
            int eoff = (tq0 + 2 * qt) * DM + head * 64 + quad * 4; asm volatile("" : "+v"(eoff));
            LAS const f32x4* ol = (LAS const f32x4*)(lds + OACC_OFF) + ((w * NQT + qt) * 4) * 64 + lane;
            bf16_t* orow = Obuf + (size_t)b * SEQ * DM + eoff;
#pragma unroll
            for (int dt = 0; dt < 4; ++dt) { const f32x4 o = ol[dt * 64] + O[qt][dt] * sc; u32x2 pk; pk.x = pk2(o[0], o[1]); pk.y = pk2(o[2], o[3]); *(u32x2*)(orow + dt * 16) = pk; }
        }
    }
}

constexpr int PH_PER_LAYER = 16;
__device__ __forceinline__ bool phase_exists(int L, int k) {
    if (L >= DEPTH || k > 11) return false;
    if (k == 0) return L == 0;
    if (k >= 2 && k <= 4) return (L & 1) != 0;
    return true;
}
template <int PHM>
__device__ __forceinline__ void run_phases(const Args& a, LAS unsigned char* lds) {
    volatile LAS unsigned* bst = (volatile LAS unsigned*)(lds + 131072 + 64);
    if (threadIdx.x == 0) { bst[0] = 0u; bst[1] = 0u; }
    __syncthreads();
    XcdBarrier xbar = xcd_barrier_post((unsigned*)(a.ws + WS_CTL), bst);
    int rep = 0, nsync = 0;
    for (int ph = a.ph_lo; ph < a.ph_hi; ++ph) {
        int tid = threadIdx.x; asm volatile("" : "+v"(tid));
        int bid = blockIdx.x; asm volatile("" : "+s"(bid));
        int G = gridDim.x; asm volatile("" : "+s"(G));
        size_t zoff = 0; asm volatile("" : "+s"(zoff)); unsigned char* ws = a.ws + zoff;
        const int lane = tid & 63, wave = __builtin_amdgcn_readfirstlane(tid >> 6);
        const int gw = bid * 8 + wave, NGW = G * 8, gtid = bid * 512 + tid, NT = G * 512;
        bf16_t* WIN = (bf16_t*)(ws + WS_WIN); bf16_t* WO = (bf16_t*)(ws + WS_WO); bf16_t* WGU = (bf16_t*)(ws + WS_WGU); bf16_t* WDN = (bf16_t*)(ws + WS_WDN); bf16_t* WC1 = (bf16_t*)(ws + WS_WC1);
        bf16_t* H = (bf16_t*)(ws + WS_H); bf16_t* PROJ = (bf16_t*)(ws + WS_PROJ); bf16_t* OB = (bf16_t*)(ws + WS_O); float* MIX = (float*)(ws + WS_MIX); bf16_t* MIXB = (bf16_t*)(ws + WS_MIX);
        bf16_t* ACMP = (bf16_t*)(ws + WS_ACMP); bf16_t* HID = (bf16_t*)(ws + WS_HID); bf16_t* KVC = (bf16_t*)(ws + WS_KVC); bf16_t* ACT = (bf16_t*)(ws + WS_ACT); bf16_t* SBG0 = (bf16_t*)(ws + WS_GU); bf16_t* SBU0 = SBG0 + (size_t)(MTOK / 64) * 2 * DFF; bf16_t* SBG1 = SBU0 + (size_t)(MTOK / 64) * 2 * DFF;
        const float* norm_g = a.in[1];
        const int L = ph / PH_PER_LAYER, k = ph % PH_PER_LAYER;
        if (!phase_exists(L, k)) continue;
        const int j = L >> 1; const bool nsa = (L & 1) != 0;
        const float* gL = norm_g + (size_t)L * 4 * DM;
#ifndef DUPM
#define DUPM 0
#endif
#ifndef DUPPAR
#define DUPPAR 3
#endif
        const int nrep = (((DUPM >> k) & 1) && ((DUPPAR >> (L & 1)) & 1)) ? 2 : 1;
        const int kk = ((PHM >> k) & 1) ? k : -1;
        switch (kk) {
        case 0: { convert_weights(a, 0, lds, gw, NGW, wave, lane); row_phase(nullptr, a.in[0], nullptr, nullptr, gL, H, gw, NGW, lane); } break;
        case 1: case 6: case 10: {
            pg8::Gemm g; pg8::EpiBf16<0> E; int N;
            if (k == 1) { N = nsa ? NSA_LD : SWA_N; g = pg8::Gemm{H, WIN, MTOK, N, DM}; E = pg8::EpiBf16<0>{PROJ, N, nsa ? nullptr : a.in[3] + (size_t)j * SWA_N}; }
            else if (k == 6) { N = DM; g = pg8::Gemm{OB, WO, MTOK, DM, DM}; E = pg8::EpiBf16<0>{MIXB, DM, nsa ? nullptr : a.in[6] + (size_t)j * DM}; }
            else { N = DM; g = pg8::Gemm{ACT, WDN, MTOK, DM, DFF}; E = pg8::EpiBf16<0>{MIXB, DM, nullptr}; }
            pg8::StaticOrder S; S.init(MTOK, N, G, bid);
            pg8::gemm_phase<pg8::EpiBf16<0>, pg8::StaticOrder, true, true>(lds, g, S, E, tid);
        } break;
        case 8: {
            pg8::Gemm g{H, WGU, MTOK, GU_N, DM};
            pg8::EpiAct E{ACT, DFF, a.in[16] + (size_t)L * 3 * DFF, a.in[17] + (size_t)L * DFF, SBG0, SBU0, SBG1};
            pg8::StaticOrder S; S.init(MTOK, GU_N, G, bid);
            pg8::gemm_phase<pg8::EpiAct, pg8::StaticOrder, true, true>(lds, g, S, E, tid);
        } break;
        case 2: cmp_build(PROJ, a.in[8] + (size_t)j * 2 * 32 * 64, ACMP, gtid, NT); break;
        case 3: {
            for (int kv = 0; kv < 2; ++kv) {
                pg8::Gemm g{ACMP + (size_t)kv * CMP_ROWS * 2048, WC1 + (size_t)kv * 512 * DM, CMP_ROWS, 512, DM};
                pg8::EpiBf16<2> E{HID + (size_t)kv * CMP_ROWS * 512, 512, a.in[10] + (size_t)(j * 2 + kv) * 512};
                pg8::StaticOrder S; S.init(CMP_ROWS, 512, G, (bid + G - 32 * kv) % G);
                pg8::gemm_phase<pg8::EpiBf16<2>, pg8::StaticOrder, true, true>(lds, g, S, E, tid);
            }
        } break;
        case 4: cmp_out(HID, a.in[11] + (size_t)j * 2 * 512 * 64, a.in[12] + (size_t)j * 2 * 64, KVC, lds, tid, gw, NGW); break;
        case 5: {
            for (int r = 0; r * G < NUNIT; ++r) {
                const int R = r * G + ((r & 1) ? (G - 1 - bid) : bid);
                if (R >= NUNIT) continue;
                const int unit = (R & 7) * QBN + (QBN - 1 - (R >> 3));
                if (nsa) nsa_unit(PROJ, KVC, MIX, OB, unit, lds, tid); else swa_unit(PROJ, a.in[4] + (size_t)j * 32, OB, unit, lds, tid);
            }
        } break;
        case 7: row_phase(MIXB, L == 0 ? a.in[0] : a.out, a.out, gL + DM, gL + 2 * DM, H, gw, NGW, lane); break;
        case 9: act_fixup(SBG0, SBU0, SBG1, ACT, a.in[16] + (size_t)L * 3 * DFF, a.in[17] + (size_t)L * DFF, gtid, NT); break;
        case 11: {
            row_phase(MIXB, a.out, a.out, gL + 3 * DM, (L + 1 < DEPTH) ? gL + 4 * DM : nullptr, H, gw, NGW, lane);
            if (L + 1 < DEPTH) { __syncthreads(); convert_weights(a, L + 1, lds, gw, NGW, wave, lane);
                if ((DUPM >> 12) & 1) { __syncthreads(); convert_weights(a, L + 1, lds, gw, NGW, wave, lane); } }
        } break;
        default: break;
        }
        if (a.coop) { bool more = false; for (int p2 = ph + 1; p2 < a.ph_hi; ++p2) if (phase_exists(p2 / PH_PER_LAYER, p2 % PH_PER_LAYER)) { more = true; break; } if (more) { if (a.coop < 0) cg::this_grid().sync(); else xcd_barrier(xbar); ++nsync; } }
        else __syncthreads();
        if (nrep == 2 && rep == 0) { rep = 1; --ph; } else rep = 0;
    }
    if ((DUPM >> 13) & 1) { for (int i = 0; i < 20; ++i) xcd_barrier(xbar); }
}
template <int PHM>
__global__ void __launch_bounds__(512, 2) fwd(Args a) {
    extern __shared__ __attribute__((aligned(16))) unsigned char lds_raw[];
    run_phases<PHM>(a, (LAS unsigned char*)lds_raw);
}

#ifndef ONE_LAUNCH
#define ONE_LAUNCH 1
#endif
constexpr int PHM_ALL = 0xFFF;
#if !ONE_LAUNCH
static const void* phase_kernel(int k) {
    switch (k) {
    case 0: return (const void*)fwd<1 << 0>;
    case 1: case 8: return (const void*)fwd<(1 << 1) | (1 << 8)>;
    case 2: return (const void*)fwd<1 << 2>;
    case 3: return (const void*)fwd<1 << 3>;
    case 4: return (const void*)fwd<1 << 4>;
    case 5: return (const void*)fwd<1 << 5>;
    case 6: case 10: return (const void*)fwd<(1 << 6) | (1 << 10)>;
    case 7: return (const void*)fwd<1 << 7>;
    case 9: return (const void*)fwd<1 << 9>;
    default: return (const void*)fwd<1 << 11>;
    }
}
#endif
extern "C" void kernel_launch(void* const* d_in, const int* in_sizes, int n_in, void* d_out, int out_size, void* d_ws, size_t ws_size, hipStream_t stream) {
    static int grid = 0;
    if (grid == 0) {
        if (n_in != 19 || out_size != MTOK * DM || ws_size < WS_END) { fprintf(stderr, "kernel_launch: unexpected shapes n_in %d out %d ws %zu (need %zu)\n", n_in, out_size, ws_size, (size_t)WS_END); grid = -1; return; }
        int dev = 0, cus = 0, per_cu = 0;
        (void)hipGetDevice(&dev); (void)hipDeviceGetAttribute(&cus, hipDeviceAttributeMultiprocessorCount, dev);
#if ONE_LAUNCH
        if (hipFuncSetAttribute((const void*)fwd<PHM_ALL>, hipFuncAttributeMaxDynamicSharedMemorySize, LDS_BYTES) != hipSuccess) { fprintf(stderr, "kernel_launch: hipFuncSetAttribute failed\n"); grid = -1; return; }
        (void)hipOccupancyMaxActiveBlocksPerMultiprocessor(&per_cu, (const void*)fwd<PHM_ALL>, 512, LDS_BYTES);
#else
        for (int k = 0; k < 12; ++k) if (hipFuncSetAttribute(phase_kernel(k), hipFuncAttributeMaxDynamicSharedMemorySize, LDS_BYTES) != hipSuccess) { fprintf(stderr, "kernel_launch: hipFuncSetAttribute failed\n"); grid = -1; return; }
#endif
        (void)hipGetLastError();
        grid = cus > 0 ? cus : 256;
        fprintf(stderr, "kernel_launch: grid %d (cus %d, per_cu %d), ws %zu\n", grid, cus, per_cu, ws_size);
    }
    if (grid < 0) return;
    Args a{};
    for (int i = 0; i < 19; ++i) a.in[i] = (const float*)d_in[i];
    a.out = (float*)d_out; a.ws = (unsigned char*)d_ws;
#if ONE_LAUNCH
    (void)hipMemsetAsync((char*)d_ws + WS_CTL, 0, CTL_BYTES, stream);
    a.ph_lo = 0; a.ph_hi = DEPTH * PH_PER_LAYER; a.coop = 1;
    void* kargs[] = {&a};
    hipError_t e = hipLaunchCooperativeKernel((const void*)fwd<PHM_ALL>, dim3(grid), dim3(512), kargs, LDS_BYTES, stream);
    if (e != hipSuccess) fprintf(stderr, "cooperative launch failed: %s (grid %d)\n", hipGetErrorString(e), grid);
#else
    for (int ph = 0; ph < DEPTH * PH_PER_LAYER; ++ph) {
        const int L = ph / PH_PER_LAYER, k = ph % PH_PER_LAYER;
        if (L >= DEPTH || k > 11 || (k == 0 && L != 0) || (k >= 2 && k <= 4 && !(L & 1))) continue;
        a.ph_lo = ph; a.ph_hi = ph + 1; a.coop = 0;
        void* kargs[] = {&a};
        hipError_t e = hipLaunchKernel(phase_kernel(k), dim3(grid), dim3(512), kargs, LDS_BYTES, stream);
        if (e != hipSuccess) { fprintf(stderr, "launch failed: %s (phase %d)\n", hipGetErrorString(e), ph); break; }
    }
#endif
}
```

```cpp
#include <hip/hip_runtime.h>
#include <hip/hip_cooperative_groups.h>
#include <cstdio>
#include <cstdint>
namespace cg = cooperative_groups;
namespace pg8 {
#define PG8_LAS __attribute__((address_space(3)))
typedef unsigned short bf16_t;
typedef short bf16x8 __attribute__((ext_vector_type(8)));
typedef float f32x4 __attribute__((ext_vector_type(4)));
typedef unsigned u32x4 __attribute__((ext_vector_type(4)));
constexpr int BM = 256, BK = 64, HALF = 128, HTB = HALF * BK * 2  , STAGE_BYTES = 8 * HTB, NXCD = 8, WGM = 8;

__host__ __device__ __forceinline__ int lds_byte(int r, int c) { const int st = (r >> 4) * 2 + (c >> 5), rr = r & 15, cc = c & 31, ob = rr * 64 + cc * 2; return st * 1024 + (ob ^ (((ob >> 9) & 1) << 5)); }
__host__ __device__ __forceinline__ void stage_rc(int b, int& R, int& C) { const int st = b / 1024, sb = b % 1024, swz = sb ^ (((sb >> 9) & 1) << 5); R = (st >> 1) * 16 + swz / 64; C = (st & 1) * 32 + (swz % 64) / 2; }
__host__ __device__ __forceinline__ int perm32(int rho) { const int n = rho >> 4, i = rho & 15; return 8 * (i >> 2) + 4 * n + (i & 3); }

struct Unit { int pm, pn; };
struct Gemm { const bf16_t* A; const bf16_t* Bt; int M, N, K; };

struct StaticOrder {
    int nM, nN, nwg, G, c;
    __host__ __device__ void init(int M, int N, int G_, int c_) { nM = M / BM; nN = N / BM; nwg = nM * nN; G = G_; c = c_; }
    __host__ __device__ bool next(int i, Unit& u) const {
        const long L = (long)i * G + c; if (L >= nwg) return false;
        int wgid = (int)L; { const int q = nwg / NXCD, r = nwg % NXCD, xcd = wgid % NXCD, off = wgid / NXCD; wgid = (xcd < r ? xcd * (q + 1) : r * (q + 1) + (xcd - r) * q) + off; }
        const int nig = WGM * nN, gid = wgid / nig, fm = gid * WGM, gsz = (nM - fm) < WGM ? (nM - fm) : WGM;
        u.pm = fm + ((wgid % nig) % gsz); u.pn = (wgid % nig) / gsz; return true;
    }
    __device__ __forceinline__ void a_ready(const Unit&) const {}
    __device__ __forceinline__ void done(const Unit&) const {}
};

__device__ __forceinline__ unsigned cvt_pk_bf16(float lo, float hi) { unsigned r; asm volatile("v_cvt_pk_bf16_f32 %0, %1, %2" : "=v"(r) : "v"(lo), "v"(hi)); return r; }
__device__ __forceinline__ float gelu_tanh(float x) { const float u = 0.7978845608028654f * (x + 0.044715f * x * x * x); return x * __builtin_amdgcn_rcpf(1.0f + __builtin_amdgcn_exp2f(-2.0f * 1.4426950408889634f * u)); }
template <int ACT> struct EpiBf16 {
    static constexpr bool PERM = true, AFTER_DRAIN = false;
    bf16_t* O; int ldc; const float* bias;
    __device__ __forceinline__ void operator()(const f32x4 (&acc)[2][2][4][2], const Unit& u, int wr, int wc, int fr, int fq) const {
        const int row0 = u.pm * BM + wr * 64 + fr; const int col0 = u.pn * BM + wc * 32 + 8 * fq;
        f32x4 bv[2][2];
#pragma unroll
        for (int bj = 0; bj < 2; ++bj)
#pragma unroll
            for (int n = 0; n < 2; ++n) bv[bj][n] = bias ? *(const f32x4*)(bias + col0 + bj * HALF + 4 * n) : (f32x4){0.f, 0.f, 0.f, 0.f};
#pragma unroll
        for (int ai = 0; ai < 2; ++ai)
#pragma unroll
            for (int m = 0; m < 4; ++m) { bf16_t* rowp = O + (size_t)(row0 + ai * HALF + m * 16) * ldc + col0;
#pragma unroll
                for (int bj = 0; bj < 2; ++bj) { f32x4 v0 = acc[ai][bj][m][0] + bv[bj][0], v1 = acc[ai][bj][m][1] + bv[bj][1];
                    if (ACT == 2) { v0 = (f32x4){gelu_tanh(v0[0]), gelu_tanh(v0[1]), gelu_tanh(v0[2]), gelu_tanh(v0[3])}; v1 = (f32x4){gelu_tanh(v1[0]), gelu_tanh(v1[1]), gelu_tanh(v1[2]), gelu_tanh(v1[3])}; }
                    u32x4 w; w.x = cvt_pk_bf16(v0[0], v0[1]); w.y = cvt_pk_bf16(v0[2], v0[3]); w.z = cvt_pk_bf16(v1[0], v1[1]); w.w = cvt_pk_bf16(v1[2], v1[3]);
                    *(u32x4*)(rowp + bj * HALF) = w; } }
    }
};
struct EpiF32 {
    static constexpr bool PERM = false, AFTER_DRAIN = false;
    float* O; int ldc; const float* bias;
    __device__ __forceinline__ void operator()(const f32x4 (&acc)[2][2][4][2], const Unit& u, int wr, int wc, int fr, int fq) const {
        const int row0 = u.pm * BM + wr * 64 + fr; const int col0 = u.pn * BM + wc * 32 + 4 * fq;
        f32x4 bv[2][2];
#pragma unroll
        for (int bj = 0; bj < 2; ++bj)
#pragma unroll
            for (int n = 0; n < 2; ++n) bv[bj][n] = bias ? *(const f32x4*)(bias + col0 + bj * HALF + 16 * n) : (f32x4){0.f, 0.f, 0.f, 0.f};
#pragma unroll
        for (int ai = 0; ai < 2; ++ai)
#pragma unroll
            for (int m = 0; m < 4; ++m) { float* rowp = O + (size_t)(row0 + ai * HALF + m * 16) * ldc + col0;
#pragma unroll
                for (int bj = 0; bj < 2; ++bj)
#pragma unroll
                    for (int n = 0; n < 2; ++n) *(f32x4*)(rowp + bj * HALF + 16 * n) = acc[ai][bj][m][n] + bv[bj][n]; }
    }
};

__device__ __forceinline__ float dpp_f(float oldv, float src, const int ctrl_sel) {
    const int o = __builtin_bit_cast(int, oldv), s = __builtin_bit_cast(int, src); int r;
    if (ctrl_sel == 0) r = __builtin_amdgcn_update_dpp(o, s, 0x121, 0xF, 0xF, false);
    else if (ctrl_sel == 1) r = __builtin_amdgcn_update_dpp(o, s, 0x111, 0xF, 0xF, false);
    else if (ctrl_sel == 2) r = __builtin_amdgcn_update_dpp(o, s, 0x122, 0xF, 0xF, false);
    else r = __builtin_amdgcn_update_dpp(o, s, 0x112, 0xF, 0xF, false);
    return __builtin_bit_cast(float, r);
}
struct EpiAct {
    static constexpr bool PERM = true, AFTER_DRAIN = false;
    bf16_t* ACT; int dff; const float* cw; const float* cb; bf16_t* SBG0; bf16_t* SBU0; bf16_t* SBG1;
    __device__ __forceinline__ void operator()(const f32x4 (&acc)[2][2][4][2], const Unit& u, int wr, int wc, int fr, int fq) const {
        const int f0 = u.pn * HALF + wc * 32 + 8 * fq;
        float w0[8], w1[8], w2[8], bb[8];
#pragma unroll
        for (int h = 0; h < 2; ++h) { const f32x4 a0 = *(const f32x4*)(cw + f0 + 4 * h), a1 = *(const f32x4*)(cw + dff + f0 + 4 * h), a2 = *(const f32x4*)(cw + 2 * dff + f0 + 4 * h), a3 = *(const f32x4*)(cb + f0 + 4 * h);
#pragma unroll
            for (int e = 0; e < 4; ++e) { w0[4 * h + e] = a0[e]; w1[4 * h + e] = a1[e]; w2[4 * h + e] = a2[e]; bb[4 * h + e] = a3[e]; } }
#pragma unroll
        for (int ai = 0; ai < 2; ++ai) {
            const int grp = u.pm * 4 + ai * 2 + wr;
            float pg[8];
#pragma unroll
            for (int e = 0; e < 8; ++e) pg[e] = 0.f;
#pragma unroll
            for (int m = 0; m < 4; ++m) {
                float g[8], up[8], o[8];
#pragma unroll
                for (int e = 0; e < 8; ++e) { g[e] = acc[ai][0][m][e >> 2][e & 3]; up[e] = acc[ai][1][m][e >> 2][e & 3]; }
#pragma unroll
                for (int e = 0; e < 8; ++e) {
                    const float t1 = dpp_f(0.f, pg[e], 0); const float g1 = dpp_f(t1, g[e], 1);
                    const float t2 = dpp_f(0.f, pg[e], 2); const float g2 = dpp_f(t2, g[e], 3);
                    const float av = bb[e] + w0[e] * g2 + w1[e] * g1 + w2[e] * g[e];
                    o[e] = av * __builtin_amdgcn_rcpf(1.0f + __builtin_amdgcn_exp2f(-1.4426950408889634f * av)) * up[e];
                }
                const int row = u.pm * BM + ai * HALF + wr * 64 + m * 16 + fr;
                u32x4 ov; ov.x = cvt_pk_bf16(o[0], o[1]); ov.y = cvt_pk_bf16(o[2], o[3]); ov.z = cvt_pk_bf16(o[4], o[5]); ov.w = cvt_pk_bf16(o[6], o[7]);
                *(u32x4*)(ACT + (size_t)row * dff + f0) = ov;
                if (m == 0 && fr < 2) {
                    u32x4 gv; gv.x = cvt_pk_bf16(g[0], g[1]); gv.y = cvt_pk_bf16(g[2], g[3]); gv.z = cvt_pk_bf16(g[4], g[5]); gv.w = cvt_pk_bf16(g[6], g[7]);
                    u32x4 uv; uv.x = cvt_pk_bf16(up[0], up[1]); uv.y = cvt_pk_bf16(up[2], up[3]); uv.z = cvt_pk_bf16(up[4], up[5]); uv.w = cvt_pk_bf16(up[6], up[7]);
                    *(u32x4*)(SBG0 + (size_t)(grp * 2 + fr) * dff + f0) = gv; *(u32x4*)(SBU0 + (size_t)(grp * 2 + fr) * dff + f0) = uv;
                }
                if (m == 3 && fr >= 14) {
                    u32x4 gv; gv.x = cvt_pk_bf16(g[0], g[1]); gv.y = cvt_pk_bf16(g[2], g[3]); gv.z = cvt_pk_bf16(g[4], g[5]); gv.w = cvt_pk_bf16(g[6], g[7]);
                    *(u32x4*)(SBG1 + (size_t)(grp * 2 + fr - 14) * dff + f0) = gv;
                }
#pragma unroll
                for (int e = 0; e < 8; ++e) pg[e] = g[e];
            }
        }
    }
};
template <class Epi, class Sched, bool ALIGN_EPI = false, bool SP2 = false>
__device__ __forceinline__ void gemm_phase(PG8_LAS unsigned char* lds, const Gemm g, const Sched& S, const Epi& E, const int tid) {
    const int wid = __builtin_amdgcn_readfirstlane(tid >> 6), lane = tid & 63, wr = wid >> 2, wc = wid & 3, fr = lane & 15, fq = lane >> 4;
    const int K = g.K, nt = K / BK;
    unsigned voffA[2], voffB[2];
#pragma unroll
    for (int i = 0; i < 2; ++i) { int R, C; stage_rc(tid * 16 + i * 8192, R, C); const int Rb = Epi::PERM ? ((R & ~31) + perm32(R & 31)) : R;
        voffA[i] = (unsigned)(R * K + C) * 2u; voffB[i] = (unsigned)(Rb * K + C) * 2u; }
    const size_t kstep = (size_t)(BK * 2);
    const size_t hstep = (size_t)HALF * K * 2;
    const size_t tstep = 2 * hstep;
    const unsigned ldsw = (unsigned)wid * 1024u;
    const int aoff = lds_byte(wr * 64 + fr, fq * 8), boff = lds_byte(wc * 32 + fr, fq * 8);
#define PG8_SA(b, h) (((b) * 2 + (h)) * HTB)
#define PG8_SB(b, h) ((4 + (b) * 2 + (h)) * HTB)
#define PG8_STAGE(bufoff, gbase, voff) do { _Pragma("unroll") for (int _i = 0; _i < 2; ++_i) \
        __builtin_amdgcn_global_load_lds((const unsigned*)((const char*)(gbase) + (voff)[_i]), (PG8_LAS unsigned*)(lds + (bufoff) + ldsw + _i * 8192), 16, 0, 0); } while (0)
#define PG8_LDA(dst, b, h) do { _Pragma("unroll") for (int m = 0; m < 4; ++m) _Pragma("unroll") for (int k = 0; k < 2; ++k) dst[m][k] = *(const PG8_LAS bf16x8*)(lds + PG8_SA(b, h) + aoff + m * 2048 + k * 1024); } while (0)
#define PG8_LDB(dst, b, h) do { _Pragma("unroll") for (int n = 0; n < 2; ++n) _Pragma("unroll") for (int k = 0; k < 2; ++k) dst[n][k] = *(const PG8_LAS bf16x8*)(lds + PG8_SB(b, h) + boff + n * 2048 + k * 1024); } while (0)
#define PG8_MMA(ai, bj, At, Bt) do { __builtin_amdgcn_s_setprio(1); _Pragma("unroll") for (int m = 0; m < 4; ++m) _Pragma("unroll") for (int n = 0; n < 2; ++n) _Pragma("unroll") for (int k = 0; k < 2; ++k) \
        acc[ai][bj][m][n] = __builtin_amdgcn_mfma_f32_16x16x32_bf16(Bt[n][k], At[m][k], acc[ai][bj][m][n], 0, 0, 0); __builtin_amdgcn_s_setprio(0); } while (0)
#define PG8_WAIT_V(n) asm volatile("s_waitcnt vmcnt(" #n ")" ::: "memory")
#define PG8_WAIT_L(n) asm volatile("s_waitcnt lgkmcnt(" #n ")" ::: "memory")
#define PG8_BAR __builtin_amdgcn_s_barrier()
#define PG8_SCHED __builtin_amdgcn_sched_barrier(0)
    Unit cur, nxt; int ui = 0;
    if (!S.next(0, cur)) return;
    f32x4 acc[2][2][4][2];
#pragma unroll
    for (int a = 0; a < 2; ++a)
#pragma unroll
        for (int b = 0; b < 2; ++b)
#pragma unroll
            for (int m = 0; m < 4; ++m)
#pragma unroll
                for (int n = 0; n < 2; ++n) acc[a][b][m][n] = (f32x4){0.f, 0.f, 0.f, 0.f};
    bf16x8 At[4][2], B0[2][2], B1[2][2];
    const char* cA = (const char*)g.A + (size_t)cur.pm * tstep; const char* cB = (const char*)g.Bt + (size_t)cur.pn * tstep;
    S.a_ready(cur);
    if constexpr (SP2) {
        PG8_STAGE(PG8_SB(0, 0), cB, voffB); PG8_STAGE(PG8_SB(0, 1), cB + hstep, voffB); PG8_STAGE(PG8_SA(0, 0), cA, voffA); PG8_STAGE(PG8_SA(0, 1), cA + hstep, voffA);
        if (wr == 1) PG8_BAR;
        PG8_WAIT_V(2); PG8_BAR;
        PG8_STAGE(PG8_SB(1, 0), cB + kstep, voffB); PG8_STAGE(PG8_SA(1, 0), cA + kstep, voffA); PG8_STAGE(PG8_SB(1, 1), cB + hstep + kstep, voffB);
        PG8_WAIT_V(6); PG8_BAR;
    } else {
        PG8_STAGE(PG8_SB(0, 0), cB, voffB); PG8_STAGE(PG8_SA(0, 0), cA, voffA); PG8_STAGE(PG8_SB(0, 1), cB + hstep, voffB); PG8_STAGE(PG8_SA(0, 1), cA + hstep, voffA);
        if (wr == 1) PG8_BAR;
        PG8_WAIT_V(4); PG8_BAR;
        PG8_STAGE(PG8_SB(1, 0), cB + kstep, voffB); PG8_STAGE(PG8_SA(1, 0), cA + kstep, voffA); PG8_STAGE(PG8_SB(1, 1), cB + hstep + kstep, voffB);
        PG8_WAIT_V(6); PG8_BAR;
    }
    for (;;) {
        const bool has_next = S.next(ui + 1, nxt);
        const char* nA = has_next ? (const char*)g.A + (size_t)nxt.pm * tstep : cA; const char* nB = has_next ? (const char*)g.Bt + (size_t)nxt.pn * tstep : cB;
        for (int t = 0; t < nt; t += 2) {
            const bool last = (t == nt - 2);
            const char* a1 = cA + (size_t)(t + 1) * kstep;
            const char* a2 = last ? nA : cA + (size_t)(t + 2) * kstep; const char* b2 = last ? nB : cB + (size_t)(t + 2) * kstep;
            const char* a3 = a2 + kstep; const char* b3 = b2 + kstep;
            if (last && has_next) S.a_ready(nxt);
            if constexpr (SP2) {
            PG8_LDB(B0, 0, 0); PG8_LDB(B1, 0, 1); PG8_SCHED; PG8_LDA(At, 0, 0); PG8_STAGE(PG8_SA(1, 1), a1 + hstep, voffA);
            PG8_WAIT_V(8); PG8_WAIT_L(0); PG8_BAR; PG8_MMA(0, 0, At, B0); PG8_MMA(0, 1, At, B1); PG8_BAR; PG8_SCHED;
            PG8_LDA(At, 0, 1); PG8_STAGE(PG8_SB(0, 0), b2, voffB); PG8_STAGE(PG8_SB(0, 1), b2 + hstep, voffB); PG8_STAGE(PG8_SA(0, 0), a2, voffA);
            PG8_WAIT_V(8); PG8_WAIT_L(0); PG8_BAR; PG8_MMA(1, 0, At, B0); PG8_MMA(1, 1, At, B1); PG8_BAR; PG8_SCHED;
            PG8_LDB(B0, 1, 0); PG8_LDB(B1, 1, 1); PG8_SCHED; PG8_LDA(At, 1, 0); PG8_STAGE(PG8_SA(0, 1), a2 + hstep, voffA);
            PG8_WAIT_V(8); PG8_WAIT_L(0); PG8_BAR; PG8_MMA(0, 0, At, B0); PG8_MMA(0, 1, At, B1); PG8_BAR; PG8_SCHED;
            PG8_LDA(At, 1, 1); PG8_STAGE(PG8_SB(1, 0), b3, voffB); PG8_STAGE(PG8_SB(1, 1), b3 + hstep, voffB); PG8_STAGE(PG8_SA(1, 0), a3, voffA);
            PG8_WAIT_V(8); PG8_WAIT_L(0); PG8_BAR; PG8_MMA(1, 0, At, B0); PG8_MMA(1, 1, At, B1); PG8_BAR; PG8_SCHED;
            } else {
            PG8_LDB(B0, 0, 0); PG8_SCHED; PG8_LDA(At, 0, 0); PG8_STAGE(PG8_SA(1, 1), a1 + hstep, voffA);
            PG8_WAIT_L(8); PG8_BAR; PG8_WAIT_L(0); PG8_MMA(0, 0, At, B0); PG8_BAR; PG8_SCHED;
            PG8_LDB(B1, 0, 1); PG8_STAGE(PG8_SB(0, 0), b2, voffB);
            PG8_BAR; PG8_WAIT_L(0); PG8_MMA(0, 1, At, B1); PG8_BAR;
            PG8_LDA(At, 0, 1); PG8_STAGE(PG8_SA(0, 0), a2, voffA);
            PG8_BAR; PG8_WAIT_L(0); PG8_MMA(1, 0, At, B0); PG8_BAR; PG8_SCHED;
            PG8_STAGE(PG8_SB(0, 1), b2 + hstep, voffB);
            PG8_WAIT_V(6); PG8_BAR; PG8_MMA(1, 1, At, B1); PG8_BAR;
            PG8_LDB(B0, 1, 0); PG8_SCHED; PG8_LDA(At, 1, 0); PG8_STAGE(PG8_SA(0, 1), a2 + hstep, voffA);
            PG8_WAIT_L(8); PG8_BAR; PG8_WAIT_L(0); PG8_MMA(0, 0, At, B0); PG8_BAR; PG8_SCHED;
            PG8_LDB(B1, 1, 1); PG8_STAGE(PG8_SB(1, 0), b3, voffB);
            PG8_BAR; PG8_WAIT_L(0); PG8_MMA(0, 1, At, B1); PG8_BAR;
            PG8_LDA(At, 1, 1); PG8_STAGE(PG8_SA(1, 0), a3, voffA);
            PG8_BAR; PG8_WAIT_L(0); PG8_MMA(1, 0, At, B0); PG8_BAR; PG8_SCHED;
            PG8_STAGE(PG8_SB(1, 1), b3 + hstep, voffB);
            PG8_WAIT_V(6); PG8_BAR; PG8_MMA(1, 1, At, B1); PG8_BAR;
            }
        }
        if constexpr (ALIGN_EPI) { if (wr == 0) PG8_BAR; }
        if constexpr (!Epi::AFTER_DRAIN) { E(acc, cur, wr, wc, fr, fq); S.done(cur); }
        if (!has_next) break;
#pragma unroll
        for (int a = 0; a < 2; ++a)
#pragma unroll
            for (int b = 0; b < 2; ++b)
#pragma unroll
                for (int m = 0; m < 4; ++m)
#pragma unroll
                    for (int n = 0; n < 2; ++n) acc[a][b][m][n] = (f32x4){0.f, 0.f, 0.f, 0.f};
        cur = nxt; cA = nA; cB = nB; ++ui;
        if constexpr (ALIGN_EPI) { if (wr == 1) PG8_BAR; }
    }
    PG8_WAIT_V(0);
    if constexpr (!ALIGN_EPI) { if (wr == 0) PG8_BAR; }
    PG8_BAR;
    if constexpr (Epi::AFTER_DRAIN) { E.fused(acc, cur, wr, wc, fr, fq, lds, wid, lane); S.done(cur); }
#undef PG8_SA
#undef PG8_SB
#undef PG8_STAGE
#undef PG8_LDA
#undef PG8_LDB
#undef PG8_MMA
#undef PG8_WAIT_V
#undef PG8_WAIT_L
#undef PG8_BAR
#undef PG8_SCHED
}
}

#define LAS __attribute__((address_space(3)))
typedef unsigned short bf16_t;
typedef short bf16x8 __attribute__((ext_vector_type(8)));
typedef short s16x4 __attribute__((ext_vector_type(4)));
typedef float f32x4 __attribute__((ext_vector_type(4)));
typedef unsigned u32x4 __attribute__((ext_vector_type(4)));
typedef unsigned u32x2 __attribute__((ext_vector_type(2)));

constexpr int SEQ = 8192, NBATCH = 2, MTOK = NBATCH * SEQ, DM = 2048, DFF = 5632, DEPTH = 4;
constexpr int SWA_N = 2560, NSA_N = 3680, NSA_LD = 3840, GU_N = 2 * DFF;
constexpr int NCMP = 511, CMP_ROWS = 4096;
constexpr float RMS_EPS = 1e-6f, LOG2E = 1.4426950408889634f, QSC = 0.125f * 1.4426950408889634f;
constexpr size_t MiB = 1u << 20;
constexpr size_t WS_WIN = 0, WS_WO = 16 * MiB, WS_WGU = 24 * MiB, WS_WDN = 68 * MiB, WS_WC1 = 90 * MiB, WS_H = 96 * MiB;
constexpr size_t WS_PROJ = 160 * MiB, WS_O = 280 * MiB, WS_MIX = 344 * MiB, WS_ACMP = 472 * MiB, WS_HID = 504 * MiB, WS_KVC = 512 * MiB;
constexpr size_t WS_CTL = 94 * MiB, CTL_BYTES = 16384;
constexpr size_t WS_GU = 160 * MiB, WS_ACT = 520 * MiB, WS_END = 696 * MiB;
constexpr int ROWE = 80;
constexpr int KS_OFF = 0, KS_BYTES = 64 * ROWE * 2, VT_OFF = 2 * KS_BYTES, VT_BYTES = 64 * ROWE * 2, IMP_OFF = 2 * KS_BYTES + 2 * VT_BYTES, SELM_OFF = IMP_OFF + 16384, UNI_OFF = SELM_OFF + 1024, OACC_OFF = UNI_OFF + 1024;
static_assert(OACC_OFF + 65536 <= 131072, "attention LDS map");
constexpr int LDS_BYTES = 131072 + 1024;

struct Args { const float* in[19]; float* out; unsigned char* ws; int ph_lo, ph_hi, coop, pad; };

__device__ __forceinline__ float bf2f(unsigned short v) { return __uint_as_float(((unsigned)v) << 16); }
__device__ __forceinline__ float bflo(unsigned v) { return __uint_as_float(v << 16); }
__device__ __forceinline__ float bfhi(unsigned v) { return __uint_as_float(v & 0xffff0000u); }
typedef float f32x2_t __attribute__((ext_vector_type(2))); typedef __bf16 bf16x2_t __attribute__((ext_vector_type(2)));
__device__ __forceinline__ unsigned pk2(float lo, float hi) { f32x2_t v = {lo, hi}; bf16x2_t b = __builtin_convertvector(v, bf16x2_t); return __builtin_bit_cast(unsigned, b); }
__device__ __forceinline__ float wave_sum(float v) {
#pragma unroll
    for (int o = 1; o < 64; o <<= 1) v += __shfl_xor(v, o);
    return v;
}


#define GAS __attribute__((address_space(1)))
typedef GAS unsigned gu32;
#define XB_TMO      128
#define XB_XCNT(j)  (256  + 64 * (j))
#define XB_XSUB(j)  (1280 + 64 * (j))
#define XB_XGEN(j)  (2304 + 64 * (j))
#define XB_TOP      3328
#define XB_TOPGEN   3392
#define XCD_BAR_WORDS 3456
#define XB_SPIN_CAP (1u << 18)

__device__ __forceinline__ unsigned xb_ld(unsigned* p)              { return __hip_atomic_load(p, __ATOMIC_RELAXED, __HIP_MEMORY_SCOPE_AGENT); }
__device__ __forceinline__ unsigned xb_add(unsigned* p, unsigned v) { return __hip_atomic_fetch_add(p, v, __ATOMIC_RELAXED, __HIP_MEMORY_SCOPE_AGENT); }
__device__ __forceinline__ unsigned xb_xcc_id() { return (unsigned)__builtin_amdgcn_s_getreg((3 << 11) | 20) & 0xFu; }
#define XB_SPIN(cond, bar) do { unsigned _sp = 0; while (cond) { __builtin_amdgcn_s_sleep(1); \
    if ((++_sp & 255u) == 0u) { if (xb_ld(&(bar)[XB_TMO])) break; if (_sp > XB_SPIN_CAP) { atomicAdd(&(bar)[XB_TMO], 1u); break; } } } } while (0)

struct XcdBarrier {
    unsigned* bar; unsigned x;
    volatile LAS unsigned* st;
};

__device__ __forceinline__ XcdBarrier xcd_barrier_post(unsigned* bar, volatile LAS unsigned* st) {
    XcdBarrier b; b.bar = bar; b.x = xb_xcc_id(); b.st = st;
    if (threadIdx.x == 0) (void)xb_add(&bar[XB_XCNT(b.x)], 1u);
    return b;
}
__device__ __forceinline__ void xcd_barrier_complete(unsigned* bar, unsigned x, unsigned& nloc, unsigned& nx) {
    const unsigned G = gridDim.x * gridDim.y * gridDim.z;
    unsigned sum, cnt, mine, sp = 0u;
    for (;;) {
        sum = 0u; cnt = 0u; mine = 0u;
#pragma unroll
        for (unsigned j = 0; j < 16; ++j) { const unsigned c = xb_ld(&bar[XB_XCNT(j)]); sum += c; cnt += (c > 0u) ? 1u : 0u; mine = (j == x) ? c : mine; }
        if (sum == G) break;
        __builtin_amdgcn_s_sleep(1);
        if ((++sp & 255u) == 0u) { if (xb_ld(&bar[XB_TMO])) break; if (sp > XB_SPIN_CAP) { atomicAdd(&bar[XB_TMO], 1u); break; } }
    }
    nloc = mine > 0u ? mine : 1u; nx = cnt > 0u ? cnt : 1u;
}

__device__ __forceinline__ void xcd_barrier(const XcdBarrier& b) {
    asm volatile("s_waitcnt vmcnt(0)" ::: "memory");
    __syncthreads();
    if (threadIdx.x == 0) {
        unsigned* bar = b.bar;
        __builtin_amdgcn_s_waitcnt(0);
        unsigned nloc = b.st[0], nx = b.st[1];
        if (nloc == 0u) { xcd_barrier_complete(bar, b.x, nloc, nx); b.st[0] = nloc; b.st[1] = nx; }
        const unsigned old = xb_add(&bar[XB_XSUB(b.x)], 1u);
        const unsigned gen = old / nloc;
        if (old + 1u == (gen + 1u) * nloc) {
            __builtin_amdgcn_fence(__ATOMIC_RELEASE, "agent");
            asm volatile("s_waitcnt vmcnt(0)" ::: "memory");
            const unsigned og = xb_add(&bar[XB_TOP], 1u);
            const unsigned tg = og / nx;
            if (og + 1u == (tg + 1u) * nx) xb_add(&bar[XB_TOPGEN], 1u);
            else XB_SPIN(xb_ld(&bar[XB_TOPGEN]) == tg, bar);
            __builtin_amdgcn_fence(__ATOMIC_ACQUIRE, "agent");
            xb_add(&bar[XB_XGEN(b.x)], 1u);
            asm volatile("s_waitcnt vmcnt(0)" ::: "memory");
        } else {
            XB_SPIN(xb_ld(&bar[XB_XGEN(b.x)]) == gen, bar);
            __builtin_amdgcn_fence(__ATOMIC_ACQUIRE, "agent");
            asm volatile("s_waitcnt vmcnt(0)" ::: "memory");
        }
    }
    __syncthreads();
}

__device__ __forceinline__ void transpose_item(const float* W, int K, int N, bf16_t* WT, int ilv, int add, LAS float* scr, int item, int lane) {
    const int nblk = N / 32, kb = item / nblk, nb = item % nblk, k0 = 64 * kb, n0 = 32 * nb;
#pragma unroll
    for (int i = 0; i < 8; ++i) { const int kk = 8 * i + (lane >> 3), n4 = (lane & 7) * 4; const f32x4 v = __builtin_nontemporal_load((const f32x4*)(W + (size_t)(k0 + kk) * N + n0 + n4));
        LAS float* d = scr + kk * 33 + n4; d[0] = v.x; d[1] = v.y; d[2] = v.z; d[3] = v.w; }
    asm volatile("s_waitcnt lgkmcnt(0)" ::: "memory");
    const int c = lane & 7;
#pragma unroll
    for (int j = 0; j < 4; ++j) { const int nl = (lane >> 3) + 8 * j; const LAS float* s = scr + (8 * c) * 33 + nl;
        u32x4 o; o.x = pk2(s[0 * 33], s[1 * 33]); o.y = pk2(s[2 * 33], s[3 * 33]); o.z = pk2(s[4 * 33], s[5 * 33]); o.w = pk2(s[6 * 33], s[7 * 33]);
        const int n = n0 + nl; const int row = ilv ? (((n >> 7) << 8) + (n & 127) + add) : n;
        *(u32x4*)(WT + (size_t)row * K + k0 + 8 * c) = o; }
    asm volatile("s_waitcnt lgkmcnt(0)" ::: "memory");
}
__device__ __forceinline__ void convert_weights(const Args& a, int L, LAS unsigned char* lds, int gw, int NGW, int wave, int lane) {
    LAS float* scr = (LAS float*)(lds + wave * 16384);
    const int j = L >> 1; const bool nsa = (L & 1) != 0;
    const int NIN = nsa ? NSA_N : SWA_N;
    const float* w_in = nsa ? a.in[7] + (size_t)j * DM * NSA_N : a.in[2] + (size_t)j * DM * SWA_N;
    const float* w_o = nsa ? a.in[13] + (size_t)j * DM * DM : a.in[5] + (size_t)j * DM * DM;
    const float* w_g = a.in[14] + (size_t)L * DM * DFF; const float* w_u = a.in[15] + (size_t)L * DM * DFF; const float* w_d = a.in[18] + (size_t)L * DFF * DM;
    const float* w_c = a.in[9] + (size_t)j * 2 * DM * 512;
    bf16_t* WIN = (bf16_t*)(a.ws + WS_WIN); bf16_t* WO = (bf16_t*)(a.ws + WS_WO); bf16_t* WGU = (bf16_t*)(a.ws + WS_WGU); bf16_t* WDN = (bf16_t*)(a.ws + WS_WDN); bf16_t* WC1 = (bf16_t*)(a.ws + WS_WC1);
    const int I0 = 32 * (NIN / 32), I1 = 32 * 64, I2 = 32 * (DFF / 32), I4 = (DFF / 64) * 64, I5 = nsa ? 32 * 16 : 0;
    const int total = I0 + I1 + 2 * I2 + I4 + 2 * I5;
    for (int it = gw; it < total; it += NGW) {
        int r = it;
        if (r < I0) { transpose_item(w_in, DM, NIN, WIN, 0, 0, scr, r, lane); continue; } r -= I0;
        if (r < I1) { transpose_item(w_o, DM, DM, WO, 0, 0, scr, r, lane); continue; } r -= I1;
        if (r < I2) { transpose_item(w_g, DM, DFF, WGU, 1, 0, scr, r, lane); continue; } r -= I2;
        if (r < I2) { transpose_item(w_u, DM, DFF, WGU, 1, 128, scr, r, lane); continue; } r -= I2;
        if (r < I4) { transpose_item(w_d, DFF, DM, WDN, 0, 0, scr, r, lane); continue; } r -= I4;
        if (r < I5) { transpose_item(w_c, DM, 512, WC1, 0, 0, scr, r, lane); continue; } r -= I5;
        transpose_item(w_c + (size_t)DM * 512, DM, 512, WC1 + (size_t)512 * DM, 0, 0, scr, r, lane);
    }
}

__device__ __forceinline__ void row_phase(const bf16_t* mix, const float* xsrc, float* xdst, const float* gA, const float* gB, bf16_t* H, int gw, int NGW, int lane) {
    f32x4 ga[8], gb[8];
#pragma unroll
    for (int j = 0; j < 8; ++j) { ga[j] = mix ? ((const f32x4*)gA)[lane + 64 * j] : (f32x4){0.f, 0.f, 0.f, 0.f}; gb[j] = gB ? ((const f32x4*)gB)[lane + 64 * j] : (f32x4){0.f, 0.f, 0.f, 0.f}; }
    for (int row = gw; row < MTOK; row += NGW) {
        const f32x4* xr = (const f32x4*)(xsrc + (size_t)row * DM) + lane;
        f32x4 xv[8];
#pragma unroll
        for (int j = 0; j < 8; ++j) xv[j] = __builtin_nontemporal_load(&xr[64 * j]);
        if (mix) {
            const u32x2* mr = (const u32x2*)(mix + (size_t)row * DM) + lane;
            f32x4 mv[8]; float ss = 0.f;
#pragma unroll
            for (int j = 0; j < 8; ++j) { const u32x2 mb = __builtin_nontemporal_load(&mr[64 * j]); mv[j] = (f32x4){bflo(mb.x), bfhi(mb.x), bflo(mb.y), bfhi(mb.y)}; ss += (mv[j].x * mv[j].x + mv[j].y * mv[j].y) + (mv[j].z * mv[j].z + mv[j].w * mv[j].w); }
            const float r1 = 1.0f / sqrtf(wave_sum(ss) * (1.0f / DM) + RMS_EPS);
            f32x4* xo = (f32x4*)(xdst + (size_t)row * DM) + lane;
#pragma unroll
            for (int j = 0; j < 8; ++j) { const f32x4 g = ga[j]; xv[j] = xv[j] + mv[j] * r1 * g; __builtin_nontemporal_store(xv[j], &xo[64 * j]); }
        }
        if (gB) {
            float ss = 0.f;
#pragma unroll
            for (int j = 0; j < 8; ++j) ss += (xv[j].x * xv[j].x + xv[j].y * xv[j].y) + (xv[j].z * xv[j].z + xv[j].w * xv[j].w);
            const float r2 = 1.0f / sqrtf(wave_sum(ss) * (1.0f / DM) + RMS_EPS);
            u32x2* ho = (u32x2*)(H + (size_t)row * DM) + lane;
#pragma unroll
            for (int j = 0; j < 8; ++j) { const f32x4 g = gb[j]; const f32x4 h = xv[j] * r2 * g; u32x2 o; o.x = pk2(h.x, h.y); o.y = pk2(h.z, h.w); ho[64 * j] = o; }
        }
    }
}

__device__ __forceinline__ void act_phase(const bf16_t* GU, bf16_t* ACT, const float* cw, const float* cb, int gtid, int nthreads) {
    constexpr int NFC = DFF / 8, NRB = MTOK / 16;
    for (int it = gtid; it < NFC * NRB; it += nthreads) {
        const int fc = it % NFC, rb = it / NFC, f0 = fc * 8, r0 = rb * 16;
        const int gcol = ((f0 >> 7) << 8) + (f0 & 127);
        float w0[8], w1[8], w2[8], bb[8];
#pragma unroll
        for (int e = 0; e < 8; ++e) { w0[e] = cw[f0 + e]; w1[e] = cw[DFF + f0 + e]; w2[e] = cw[2 * DFF + f0 + e]; bb[e] = cb[f0 + e]; }
        float g2[8], g1[8];
        const bool has_prev = (r0 & (SEQ - 1)) != 0;
        {
            u32x4 a2 = (u32x4){0, 0, 0, 0}, a1 = (u32x4){0, 0, 0, 0};
            if (has_prev) { a2 = *(const u32x4*)(GU + (size_t)(r0 - 2) * GU_N + gcol); a1 = *(const u32x4*)(GU + (size_t)(r0 - 1) * GU_N + gcol); }
            g2[0] = bflo(a2.x); g2[1] = bfhi(a2.x); g2[2] = bflo(a2.y); g2[3] = bfhi(a2.y); g2[4] = bflo(a2.z); g2[5] = bfhi(a2.z); g2[6] = bflo(a2.w); g2[7] = bfhi(a2.w);
            g1[0] = bflo(a1.x); g1[1] = bfhi(a1.x); g1[2] = bflo(a1.y); g1[3] = bfhi(a1.y); g1[4] = bflo(a1.z); g1[5] = bfhi(a1.z); g1[6] = bflo(a1.w); g1[7] = bfhi(a1.w);
        }
#pragma unroll 4
        for (int i = 0; i < 16; ++i) {
            const u32x4 gv = *(const u32x4*)(GU + (size_t)(r0 + i) * GU_N + gcol);
            const u32x4 uv = *(const u32x4*)(GU + (size_t)(r0 + i) * GU_N + gcol + 128);
            float g0[8], up[8], o[8];
            g0[0] = bflo(gv.x); g0[1] = bfhi(gv.x); g0[2] = bflo(gv.y); g0[3] = bfhi(gv.y); g0[4] = bflo(gv.z); g0[5] = bfhi(gv.z); g0[6] = bflo(gv.w); g0[7] = bfhi(gv.w);
            up[0] = bflo(uv.x); up[1] = bfhi(uv.x); up[2] = bflo(uv.y); up[3] = bfhi(uv.y); up[4] = bflo(uv.z); up[5] = bfhi(uv.z); up[6] = bflo(uv.w); up[7] = bfhi(uv.w);
#pragma unroll
            for (int e = 0; e < 8; ++e) { const float av = bb[e] + w0[e] * g2[e] + w1[e] * g1[e] + w2[e] * g0[e];
                o[e] = av * __builtin_amdgcn_rcpf(1.0f + __builtin_amdgcn_exp2f(-LOG2E * av)) * up[e]; g2[e] = g1[e]; g1[e] = g0[e]; }
            u32x4 ov; ov.x = pk2(o[0], o[1]); ov.y = pk2(o[2], o[3]); ov.z = pk2(o[4], o[5]); ov.w = pk2(o[6], o[7]);
            *(u32x4*)(ACT + (size_t)(r0 + i) * DFF + f0) = ov;
        }
    }
}


__device__ __forceinline__ void act_fixup(const bf16_t* SBG0, const bf16_t* SBU0, const bf16_t* SBG1, bf16_t* ACT, const float* cw, const float* cb, int gtid, int nthreads) {
    constexpr int NFC = DFF / 8, NGRP = MTOK / 64;
    for (int it = gtid; it < NFC * NGRP * 2; it += nthreads) {
        const int fc = it % NFC, gr = it / NFC, r = gr & 1, grp = gr >> 1, f0 = fc * 8;
        const bool has_prev = (grp % (SEQ / 64)) != 0;
        const u32x4 z = (u32x4){0, 0, 0, 0};
        const u32x4 own0 = *(const u32x4*)(SBG0 + (size_t)(grp * 2 + 0) * DFF + f0), own1 = *(const u32x4*)(SBG0 + (size_t)(grp * 2 + 1) * DFF + f0);
        const u32x4 upv = *(const u32x4*)(SBU0 + (size_t)(grp * 2 + r) * DFF + f0);
        const u32x4 p62 = has_prev ? *(const u32x4*)(SBG1 + (size_t)((grp - 1) * 2 + 0) * DFF + f0) : z, p63 = has_prev ? *(const u32x4*)(SBG1 + (size_t)((grp - 1) * 2 + 1) * DFF + f0) : z;
        const u32x4 a2 = r ? p63 : p62, a1 = r ? own0 : p63, a0 = r ? own1 : own0;
        float g2[8], g1[8], g0[8], up[8], o[8];
        g2[0] = bflo(a2.x); g2[1] = bfhi(a2.x); g2[2] = bflo(a2.y); g2[3] = bfhi(a2.y); g2[4] = bflo(a2.z); g2[5] = bfhi(a2.z); g2[6] = bflo(a2.w); g2[7] = bfhi(a2.w);
        g1[0] = bflo(a1.x); g1[1] = bfhi(a1.x); g1[2] = bflo(a1.y); g1[3] = bfhi(a1.y); g1[4] = bflo(a1.z); g1[5] = bfhi(a1.z); g1[6] = bflo(a1.w); g1[7] = bfhi(a1.w);
        g0[0] = bflo(a0.x); g0[1] = bfhi(a0.x); g0[2] = bflo(a0.y); g0[3] = bfhi(a0.y); g0[4] = bflo(a0.z); g0[5] = bfhi(a0.z); g0[6] = bflo(a0.w); g0[7] = bfhi(a0.w);
        up[0] = bflo(upv.x); up[1] = bfhi(upv.x); up[2] = bflo(upv.y); up[3] = bfhi(upv.y); up[4] = bflo(upv.z); up[5] = bfhi(upv.z); up[6] = bflo(upv.w); up[7] = bfhi(upv.w);
#pragma unroll
        for (int e = 0; e < 8; ++e) { const float av = cb[f0 + e] + cw[f0 + e] * g2[e] + cw[DFF + f0 + e] * g1[e] + cw[2 * DFF + f0 + e] * g0[e];
            o[e] = av * __builtin_amdgcn_rcpf(1.0f + __builtin_amdgcn_exp2f(-LOG2E * av)) * up[e]; }
        u32x4 ov; ov.x = pk2(o[0], o[1]); ov.y = pk2(o[2], o[3]); ov.z = pk2(o[4], o[5]); ov.w = pk2(o[6], o[7]);
        *(u32x4*)(ACT + (size_t)(grp * 64 + r) * DFF + f0) = ov;
    }
}
__device__ __forceinline__ void cmp_build(const bf16_t* PROJ, const float* pe  , bf16_t* ACMP, int gtid, int nthreads) {
    for (int it = gtid; it < 2 * CMP_ROWS * 256; it += nthreads) {
        const int piece = it & 255, row = (it >> 8) & (CMP_ROWS - 1), kv = it >> 20;
        u32x4 o = (u32x4){0, 0, 0, 0};
        if (row < NBATCH * NCMP * 4) {
            const int g = row & 3, bn = row >> 2, n = bn % NCMP, b = bn / NCMP, l = piece >> 3, d0 = (piece & 7) * 8;
            const u32x4 s = *(const u32x4*)(PROJ + (size_t)(b * SEQ + 16 * n + l) * NSA_LD + 2048 + kv * 256 + g * 64 + d0);
            const f32x4 p0 = *(const f32x4*)(pe + (kv * 32 + l) * 64 + d0), p1 = *(const f32x4*)(pe + (kv * 32 + l) * 64 + d0 + 4);
            o.x = pk2(bflo(s.x) + p0.x, bfhi(s.x) + p0.y); o.y = pk2(bflo(s.y) + p0.z, bfhi(s.y) + p0.w);
            o.z = pk2(bflo(s.z) + p1.x, bfhi(s.z) + p1.y); o.w = pk2(bflo(s.w) + p1.z, bfhi(s.w) + p1.w);
        }
        *(u32x4*)(ACMP + ((size_t)kv * CMP_ROWS + row) * 2048 + piece * 8) = o;
    }
}
__device__ __forceinline__ void cmp_out(const bf16_t* HID, const float* w2  , const float* b2  , bf16_t* KVC, LAS unsigned char* lds, int tid, int gw, int NGW) {
    LAS float* wl = (LAS float*)lds;
    const int lane = tid & 63;
    for (int kv = 0; kv < 2; ++kv) {
        __syncthreads();
        for (int i = tid; i < 512 * 64 / 4; i += 512) ((LAS f32x4*)wl)[i] = ((const f32x4*)(w2 + (size_t)kv * 512 * 64))[i];
        __syncthreads();
        const float bias = b2[kv * 64 + lane];
        for (int r = gw; r < 2 * 4 * 512; r += NGW) {
            const int n = r & 511, g = (r >> 9) & 3, b = r >> 11;
            float acc = 0.f;
            if (n < NCMP) {
                const int row = (b * NCMP + n) * 4 + g;
                const u32x4* hp = (const u32x4*)(HID + ((size_t)kv * CMP_ROWS + row) * 512);
                float a0 = bias, a1 = 0.f, a2 = 0.f, a3 = 0.f;
#pragma unroll 4
                for (int c8 = 0; c8 < 64; ++c8) { const u32x4 h = hp[c8]; const LAS float* w = wl + c8 * 8 * 64 + lane;
                    a0 += bflo(h.x) * w[0] + bfhi(h.x) * w[64]; a1 += bflo(h.y) * w[128] + bfhi(h.y) * w[192]; a2 += bflo(h.z) * w[256] + bfhi(h.z) * w[320]; a3 += bflo(h.w) * w[384] + bfhi(h.w) * w[448]; }
                acc = (a0 + a1) + (a2 + a3);
            }
            KVC[((size_t)kv * 4096 + r) * 64 + lane] = (bf16_t)(pk2(acc, 0.f) & 0xffffu);
        }
    }
    __syncthreads();
}

constexpr float MFLOOR = -3.0e4f;

__device__ __forceinline__ float xmax16(float v) { auto r = __builtin_amdgcn_permlane16_swap(__float_as_uint(v), __float_as_uint(v), false, false); return fmaxf(__uint_as_float(r[0]), __uint_as_float(r[1])); }
__device__ __forceinline__ float xmax32(float v) { auto r = __builtin_amdgcn_permlane32_swap(__float_as_uint(v), __float_as_uint(v), false, false); return fmaxf(__uint_as_float(r[0]), __uint_as_float(r[1])); }
__device__ __forceinline__ float xsum16(float v) { auto r = __builtin_amdgcn_permlane16_swap(__float_as_uint(v), __float_as_uint(v), false, false); return __uint_as_float(r[0]) + __uint_as_float(r[1]); }
__device__ __forceinline__ float xsum32(float v) { auto r = __builtin_amdgcn_permlane32_swap(__float_as_uint(v), __float_as_uint(v), false, false); return __uint_as_float(r[0]) + __uint_as_float(r[1]); }
template <int CTRL> __device__ __forceinline__ float dppf(float v) { return __int_as_float(__builtin_amdgcn_update_dpp(0, __float_as_int(v), CTRL, 0xF, 0xF, true)); }
template <int CTRL> __device__ __forceinline__ int dppi(int v) { return __builtin_amdgcn_update_dpp(0, v, CTRL, 0xF, 0xF, true); }
constexpr int DPP_X1 = 0xB1  , DPP_X2 = 0x4E  , DPP_HM = 0x141  , DPP_RM = 0x140  ;
constexpr int NQT = 2, UQ = 16 * NQT, NUNIT = MTOK * 4 / UQ, QBN = SEQ / UQ;
template <int MODE, int KSTRIDE, bool MASKED = true, bool SEL = false>
__device__ __forceinline__ void chunk_compute(LAS const unsigned char* Ks, LAS const unsigned char* Vt, const bf16x8 (&qf)[NQT][2], float (&m)[NQT], float (&l)[NQT], f32x4 (&O)[NQT][4], f32x4 (&L)[NQT], const bf16x8 onesf,
                                              int tq0, float sl2, int kp0, int W, unsigned selbits, int c, int quad,
                                              volatile LAS float* imp_rows, int jb0, const float (&linv)[NQT]) {
    int dbase = tq0 - kp0 - quad * 4 * KSTRIDE;
    asm volatile("" : "+v"(dbase));
    bf16x8 kf[4][2];
#pragma unroll
    for (int kt = 0; kt < 4; ++kt)
#pragma unroll
        for (int ks = 0; ks < 2; ++ks) kf[kt][ks] = *(LAS const bf16x8*)(Ks + ((kt * 16 + c) * ROWE + ks * 32 + quad * 8) * 2);
    bf16x8 pb[NQT][2]; bool act[NQT];
#pragma unroll
    for (int qt = 0; qt < NQT; ++qt) {
        const bool selq = ((selbits >> qt) & 1u) != 0u;
        act[qt] = SEL ? (__any(selq ? 1 : 0) != 0) : true;
        pb[qt][0] = (bf16x8){0, 0, 0, 0, 0, 0, 0, 0}; pb[qt][1] = pb[qt][0];
        if (!act[qt]) continue;
        f32x4 s[4];
        const int dq = dbase + 2 * qt; const float bbq = (MASKED || selq) ? -sl2 * (float)dq : -1e30f;
#pragma unroll
        for (int kt = 0; kt < 4; ++kt) {
            s[kt] = (f32x4){__builtin_fmaf(sl2, (float)((kt * 16 + 0) * KSTRIDE), bbq), __builtin_fmaf(sl2, (float)((kt * 16 + 1) * KSTRIDE), bbq), __builtin_fmaf(sl2, (float)((kt * 16 + 2) * KSTRIDE), bbq), __builtin_fmaf(sl2, (float)((kt * 16 + 3) * KSTRIDE), bbq)};
#pragma unroll
            for (int ks = 0; ks < 2; ++ks) s[kt] = __builtin_amdgcn_mfma_f32_16x16x32_bf16(kf[kt][ks], qf[qt][ks], s[kt], 0, 0, 0);
        }
        float mx = -1e30f;
        const int tqq = tq0 + 2 * qt;
        const unsigned lim = selq ? (unsigned)(W < tqq + 1 ? W : tqq + 1) : 0u;
#pragma unroll
        for (int kt = 0; kt < 4; ++kt)
#pragma unroll
            for (int j = 0; j < 4; ++j) {
                const int C = (kt * 16 + j) * KSTRIDE;
                float v = s[kt][j];
                if (MASKED) { const bool valid = (unsigned)(dq - C) < lim; v = valid ? v : -1e30f; }
                s[kt][j] = v; mx = fmaxf(mx, v);
            }
        if (MODE != 2) {
            mx = xmax32(xmax16(mx));
            const float mnew = fmaxf(m[qt], mx); const float alpha = __builtin_amdgcn_exp2f(m[qt] - mnew); m[qt] = mnew;
            float psum = 0.f;
#pragma unroll
            for (int kt = 0; kt < 4; ++kt)
#pragma unroll
                for (int j = 0; j < 4; ++j) { const float p = __builtin_amdgcn_exp2f(s[kt][j] - mnew); s[kt][j] = p; psum += p; }
            if (MODE == 1) l[qt] = l[qt] * alpha + psum;
            if (MODE == 0) {
                L[qt] = L[qt] * alpha;
#pragma unroll
                for (int dt = 0; dt < 4; ++dt) O[qt][dt] = O[qt][dt] * alpha;
            }
        } else {
#pragma unroll
            for (int kt = 0; kt < 4; ++kt)
#pragma unroll
                for (int j = 0; j < 4; ++j) { const float p = __builtin_amdgcn_exp2f(s[kt][j] - m[qt]) * linv[qt]; s[kt][j] = p; }
#pragma unroll
            for (int kt = 0; kt < 4; ++kt) {
                f32x4 hs = s[kt];
#pragma unroll
                for (int j = 0; j < 4; ++j) { hs[j] += dppf<DPP_X1>(hs[j]); hs[j] += dppf<DPP_X2>(hs[j]); hs[j] += dppf<DPP_HM>(hs[j]); }
                if ((c & 7) == 0) {
                    const int ql = qt * 2 + (c >> 3); const int jb = jb0 + kt * 4 + quad;
                    LAS float* p0 = (LAS float*)imp_rows + ql * 128 + jb;
                    (void)__hip_atomic_fetch_add(p0, (hs[0] + hs[1]) + (hs[2] + hs[3]), __ATOMIC_RELAXED, __HIP_MEMORY_SCOPE_WORKGROUP);
                    if (jb + 1 < 128) (void)__hip_atomic_fetch_add(p0 + 1, hs[3], __ATOMIC_RELAXED, __HIP_MEMORY_SCOPE_WORKGROUP);
                }
            }
        }
        if (MODE != 1) {
#pragma unroll
            for (int i = 0; i < 2; ++i) {
                u32x4 w; w.x = pk2(s[2 * i][0], s[2 * i][1]); w.y = pk2(s[2 * i][2], s[2 * i][3]); w.z = pk2(s[2 * i + 1][0], s[2 * i + 1][1]); w.w = pk2(s[2 * i + 1][2], s[2 * i + 1][3]);
                pb[qt][i] = __builtin_bit_cast(bf16x8, w);
            }
        }
    }
    if (MODE != 1) {
        bf16x8 vf[4][2];
#pragma unroll
        for (int dt = 0; dt < 4; ++dt)
#pragma unroll
            for (int i = 0; i < 2; ++i) {
                vf[dt][i] = *(LAS const bf16x8*)(Vt + ((dt * 16 + c) * ROWE + ((32 * i + quad * 8) ^ (dt * 16))) * 2);
            }
#pragma unroll
        for (int qt = 0; qt < NQT; ++qt) {
            if (!act[qt]) continue;
#pragma unroll
            for (int dt = 0; dt < 4; ++dt)
#pragma unroll
                for (int i = 0; i < 2; ++i) O[qt][dt] = __builtin_amdgcn_mfma_f32_16x16x32_bf16(vf[dt][i], pb[qt][i], O[qt][dt], 0, 0, 0);
            if (MODE == 0) {
#pragma unroll
                for (int i = 0; i < 2; ++i) L[qt] = __builtin_amdgcn_mfma_f32_16x16x32_bf16(onesf, pb[qt][i], L[qt], 0, 0, 0);
            }
        }
    }
}

__device__ __forceinline__ bf16x8 scale_q(bf16x8 q) {
    const u32x4 u = __builtin_bit_cast(u32x4, q); u32x4 o;
    o.x = pk2(bflo(u.x) * QSC, bfhi(u.x) * QSC); o.y = pk2(bflo(u.y) * QSC, bfhi(u.y) * QSC); o.z = pk2(bflo(u.z) * QSC, bfhi(u.z) * QSC); o.w = pk2(bflo(u.w) * QSC, bfhi(u.w) * QSC);
    return __builtin_bit_cast(bf16x8, o);
}
#define STG_LOAD(kp_, vp_, ld_, row_) do { const int rr_ = (row_) + (tid >> 3); if (rr_ >= 0 && rr_ < SEQ) { kreg = *(const u32x4*)((kp_) + (size_t)rr_ * (ld_) + (tid & 7) * 8); vreg = *(const u32x4*)((vp_) + (size_t)rr_ * (ld_) + (tid & 7) * 8); } \
        else { kreg = (u32x4){0, 0, 0, 0}; vreg = (u32x4){0, 0, 0, 0}; } } while (0)
#define STG_STORE(buf_) do { *(LAS u32x4*)(lds + KS_OFF + (buf_) * KS_BYTES + (tid >> 3) * (ROWE * 2) + (tid & 7) * 16) = kreg; \
        const int key_ = tid >> 3, pos_ = ((key_ & ~31) + ((key_ >> 2) & 3) * 8 + ((key_ >> 4) & 1) * 4 + (key_ & 3)) ^ (((tid & 7) >> 1) << 4);         \
        LAS bf16_t* vt_ = (LAS bf16_t*)(lds + VT_OFF + (buf_) * VT_BYTES) + ((tid & 7) * 8) * ROWE + pos_; \
        vt_[0 * ROWE] = (bf16_t)(vreg.x & 0xffffu); vt_[1 * ROWE] = (bf16_t)(vreg.x >> 16); vt_[2 * ROWE] = (bf16_t)(vreg.y & 0xffffu); vt_[3 * ROWE] = (bf16_t)(vreg.y >> 16); \
        vt_[4 * ROWE] = (bf16_t)(vreg.z & 0xffffu); vt_[5 * ROWE] = (bf16_t)(vreg.z >> 16); vt_[6 * ROWE] = (bf16_t)(vreg.w & 0xffffu); vt_[7 * ROWE] = (bf16_t)(vreg.w >> 16); } while (0)
#define KSBUF(b_) ((LAS const unsigned char*)(lds + KS_OFF + (b_) * KS_BYTES))
#define VTBUF(b_) ((LAS const unsigned char*)(lds + VT_OFF + (b_) * VT_BYTES))

__device__ __forceinline__ void swa_unit(const bf16_t* PROJ, const float* sinks, bf16_t* Obuf, int unit, LAS unsigned char* lds, const int tid) {
    const int lane = tid & 63, w = tid >> 6, c = lane & 15, quad = lane >> 4;
    const int qb = unit % QBN, kvh = (unit / QBN) & 3, b = unit / (4 * QBN), t0 = qb * UQ;
    const int head = kvh * 8 + (c & 7);
    const float sl2 = __builtin_amdgcn_exp2f(-0.25f * (float)(head + 1)) * LOG2E;
    const bf16_t* base = PROJ + (size_t)b * SEQ * SWA_N;
    const bf16_t* kp = base + 2048 + kvh * 64; const bf16_t* vp = base + 2304 + kvh * 64;
    bf16x8 qf[NQT][2]; float m[NQT], l[NQT], linv[NQT]; f32x4 O[NQT][4]; f32x4 L[NQT];
    const bf16x8 onesf = (c == 0) ? (bf16x8){0x3F80, 0x3F80, 0x3F80, 0x3F80, 0x3F80, 0x3F80, 0x3F80, 0x3F80} : (bf16x8){0, 0, 0, 0, 0, 0, 0, 0};
    const int tq0 = t0 + 2 * NQT * w + (c >> 3);
    const float sink2 = sinks[head] * LOG2E;
#pragma unroll
    for (int qt = 0; qt < NQT; ++qt) {
        m[qt] = sink2; l[qt] = 0.f; linv[qt] = 0.f; L[qt] = (f32x4){(quad == 0) ? 1.0f : 0.0f, 0.f, 0.f, 0.f};
#pragma unroll
        for (int ks = 0; ks < 2; ++ks) qf[qt][ks] = scale_q(__builtin_nontemporal_load((const bf16x8*)(base + (size_t)(tq0 + 2 * qt) * SWA_N + head * 64 + ks * 32 + quad * 8)));
#pragma unroll
        for (int dt = 0; dt < 4; ++dt) O[qt][dt] = (f32x4){0.f, 0.f, 0.f, 0.f};
    }
    u32x4 kreg, vreg;
    STG_LOAD(kp, vp, SWA_N, t0 - 128); STG_STORE(0); __syncthreads();
    for (int ci = 0; ci < 3; ++ci) {
        if (ci + 1 < 3) STG_LOAD(kp, vp, SWA_N, t0 - 128 + 64 * (ci + 1));
        chunk_compute<0, 1>(KSBUF(ci & 1), VTBUF(ci & 1), qf, m, l, O, L, onesf, tq0, sl2, t0 - 128 + 64 * ci, 128, 0xFu, c, quad, nullptr, 0, linv);
        if (ci + 1 < 3) STG_STORE((ci + 1) & 1);
        __syncthreads();
    }
#pragma unroll
    for (int qt = 0; qt < NQT; ++qt) {
        float lt = L[qt][0]; lt = xsum32(xsum16(lt));
        const float inv = 1.0f / lt;
        bf16_t* orow = Obuf + (size_t)(b * SEQ + (tq0 + 2 * qt)) * DM + head * 64 + quad * 4;
#pragma unroll
        for (int dt = 0; dt < 4; ++dt) { const f32x4 o = O[qt][dt] * inv; u32x2 pk; pk.x = pk2(o[0], o[1]); pk.y = pk2(o[2], o[3]); *(u32x2*)(orow + dt * 16) = pk; }
    }
}

#define GATE(qt_, i_) __builtin_amdgcn_rcpf(1.0f + __builtin_amdgcn_exp2f(-LOG2E * gatev[qt_][i_]))
__device__ __forceinline__ void nsa_unit(const bf16_t* PROJ, const bf16_t* KVC, float* OACC, bf16_t* Obuf, int unit, LAS unsigned char* lds, const int tid) {
    const int lane = tid & 63, w = tid >> 6, c = lane & 15, quad = lane >> 4;
    const int qb = unit % QBN, g = (unit / QBN) & 3, b = unit / (4 * QBN), t0 = qb * UQ;
    const int head = g * 8 + (c & 7);
    const float sl2 = __builtin_amdgcn_exp2f(-0.25f * (float)(head + 1)) * LOG2E;
    const bf16_t* base = PROJ + (size_t)b * SEQ * NSA_LD;
    volatile LAS float* imp_rows = (volatile LAS float*)(lds + IMP_OFF) + (2 * NQT * w) * 128;
    volatile LAS unsigned* selm = (volatile LAS unsigned*)(lds + SELM_OFF);
    volatile LAS unsigned* uni = (volatile LAS unsigned*)(lds + UNI_OFF);
    bf16x8 qf[NQT][2]; float m[NQT], l[NQT], linv[NQT]; f32x4 O[NQT][4]; f32x4 L[NQT];
    const bf16x8 onesf = (c == 0) ? (bf16x8){0x3F80, 0x3F80, 0x3F80, 0x3F80, 0x3F80, 0x3F80, 0x3F80, 0x3F80} : (bf16x8){0, 0, 0, 0, 0, 0, 0, 0};
    const int tq0 = t0 + 2 * NQT * w + (c >> 3);
#pragma unroll
    for (int qt = 0; qt < NQT; ++qt) {
        const bf16_t* prow = base + (size_t)(tq0 + 2 * qt) * NSA_LD;
#pragma unroll
        for (int ks = 0; ks < 2; ++ks) qf[qt][ks] = scale_q(__builtin_nontemporal_load((const bf16x8*)(prow + head * 64 + ks * 32 + quad * 8)));
    }
    for (int i = lane; i < 2 * NQT * 128; i += 64) imp_rows[i] = 0.f;
    float gatev[NQT][3];
#pragma unroll
    for (int qt = 0; qt < NQT; ++qt)
#pragma unroll
        for (int i = 0; i < 3; ++i) gatev[qt][i] = bf2f(base[(size_t)(tq0 + 2 * qt) * NSA_LD + 3584 + head * 3 + i]);
    u32x4 kreg, vreg;
    const bf16_t* kc = KVC + ((size_t)((0 * 2 + b) * 4 + g) * 512) * 64; const bf16_t* vc = KVC + ((size_t)((1 * 2 + b) * 4 + g) * 512) * 64;
    const int nmax = (t0 + UQ - 1 - 31) >> 4, ncc = (nmax >> 6) + 1;
    const bf16_t* ksl = base + 2560 + g * 64; const bf16_t* vsl = base + 2816 + g * 64;
    const bf16_t* kwp = base + 3072 + g * 64; const bf16_t* vwp = base + 3328 + g * 64;
    const int c0 = (t0 >= 512) ? 0 : (512 - t0) / 64;
#pragma unroll
    for (int qt = 0; qt < NQT; ++qt) { m[qt] = MFLOOR; l[qt] = 0.f; linv[qt] = 0.f; L[qt] = (f32x4){0.f, 0.f, 0.f, 0.f}; }
    STG_LOAD(kc, vc, 64, 0); STG_STORE(0); __syncthreads();
    {
        const int nun = (t0 >= 1039) ? (t0 - 1039) / 1024 + 1 : 0;
        int ci = 0;
        for (; ci < nun; ++ci) {
            STG_LOAD(kc, vc, 64, 64 * (ci + 1));
            chunk_compute<1, 16, false>(KSBUF(ci & 1), VTBUF(ci & 1), qf, m, l, O, L, onesf, tq0, sl2, 16 * (64 * ci) + 31, 1 << 30, 0xFu, c, quad, imp_rows, 0, linv);
            STG_STORE((ci + 1) & 1);
            __syncthreads();
        }
        for (; ci < ncc; ++ci) {
            STG_LOAD(kc, vc, 64, (ci + 1 < ncc) ? 64 * (ci + 1) : 0);
            chunk_compute<1, 16, true>(KSBUF(ci & 1), VTBUF(ci & 1), qf, m, l, O, L, onesf, tq0, sl2, 16 * (64 * ci) + 31, 1 << 30, 0xFu, c, quad, imp_rows, 0, linv);
            STG_STORE((ci + 1) & 1);
            __syncthreads();
        }
    }
#pragma unroll
    for (int qt = 0; qt < NQT; ++qt) {
        float lt = l[qt]; lt = xsum32(xsum16(lt)); linv[qt] = lt > 0.f ? 1.0f / lt : 0.f;
#pragma unroll
        for (int dt = 0; dt < 4; ++dt) O[qt][dt] = (f32x4){0.f, 0.f, 0.f, 0.f};
    }
    {
        const int nun = (t0 >= 1039) ? (t0 - 1039) / 1024 + 1 : 0;
        const int pb = ncc & 1;
        int ci = 0;
        for (; ci < nun; ++ci) {
            STG_LOAD(kc, vc, 64, 64 * (ci + 1));
            chunk_compute<2, 16, false>(KSBUF((ci + pb) & 1), VTBUF((ci + pb) & 1), qf, m, l, O, L, onesf, tq0, sl2, 16 * (64 * ci) + 31, 1 << 30, 0xFu, c, quad, imp_rows, 16 * ci, linv);
            STG_STORE((ci + 1 + pb) & 1);
            __syncthreads();
        }
        for (; ci < ncc; ++ci) {
            if (ci + 1 < ncc) STG_LOAD(kc, vc, 64, 64 * (ci + 1)); else STG_LOAD(ksl, vsl, NSA_LD, 0);
            chunk_compute<2, 16, true>(KSBUF((ci + pb) & 1), VTBUF((ci + pb) & 1), qf, m, l, O, L, onesf, tq0, sl2, 16 * (64 * ci) + 31, 1 << 30, 0xFu, c, quad, imp_rows, 16 * ci, linv);
            STG_STORE((ci + 1 + pb) & 1);
            __syncthreads();
        }
    }
#pragma unroll
    for (int qt = 0; qt < NQT; ++qt) {
        LAS f32x4* ol = (LAS f32x4*)(lds + OACC_OFF) + ((w * NQT + qt) * 4) * 64 + lane;
#pragma unroll
        for (int dt = 0; dt < 4; ++dt) ol[dt * 64] = O[qt][dt] * GATE(qt, 0);
    }
    {
        const int ql = lane >> 4, sub = lane & 15; const int cur = (t0 + 4 * w + ql) >> 6;
        float v[8];
#pragma unroll
        for (int i = 0; i < 8; ++i) { const int jb = sub + 16 * i; const float x = imp_rows[ql * 128 + jb]; const bool forced = (jb == 0) || (jb == cur) || (jb == cur - 1); v[i] = forced ? -2.0f : (jb <= cur ? x : -1.0f); }
        unsigned mk0 = 1u, mk1 = 0u, mk2 = 0u, mk3 = 0u;
        { const int wd = cur >> 5; const unsigned bit = 1u << (cur & 31); mk0 |= (wd == 0) ? bit : 0u; mk1 |= (wd == 1) ? bit : 0u; mk2 |= (wd == 2) ? bit : 0u; mk3 |= (wd == 3) ? bit : 0u; }
        if (cur >= 1) { const int pj = cur - 1; const int wd = pj >> 5; const unsigned bit = 1u << (pj & 31); mk0 |= (wd == 0) ? bit : 0u; mk1 |= (wd == 1) ? bit : 0u; mk2 |= (wd == 2) ? bit : 0u; mk3 |= (wd == 3) ? bit : 0u; }
        const int nforced = (cur >= 2) ? 3 : cur + 1;
        for (int round = nforced; round < 16; ++round) {
            float bv = v[0]; int bi = sub;
#pragma unroll
            for (int i = 1; i < 8; ++i) if (v[i] > bv) { bv = v[i]; bi = sub + 16 * i; }
            { float ov = dppf<DPP_X1>(bv); int oi = dppi<DPP_X1>(bi); if (ov > bv || (ov == bv && oi < bi)) { bv = ov; bi = oi; }
              ov = dppf<DPP_X2>(bv); oi = dppi<DPP_X2>(bi); if (ov > bv || (ov == bv && oi < bi)) { bv = ov; bi = oi; }
              ov = dppf<DPP_HM>(bv); oi = dppi<DPP_HM>(bi); if (ov > bv || (ov == bv && oi < bi)) { bv = ov; bi = oi; }
              ov = dppf<DPP_RM>(bv); oi = dppi<DPP_RM>(bi); if (ov > bv || (ov == bv && oi < bi)) { bv = ov; bi = oi; } }
            if (!__any(bv >= 0.f ? 1 : 0)) break;
            if (bv >= 0.f) { const unsigned bit = 1u << (bi & 31); const int wd = bi >> 5; mk0 |= (wd == 0) ? bit : 0u; mk1 |= (wd == 1) ? bit : 0u; mk2 |= (wd == 2) ? bit : 0u; mk3 |= (wd == 3) ? bit : 0u;
#pragma unroll
                for (int i = 0; i < 8; ++i) if (bi == sub + 16 * i) v[i] = -2.0f; }
        }
        if (sub == 0) { selm[(4 * w + ql) * 4 + 0] = mk0; selm[(4 * w + ql) * 4 + 1] = mk1; selm[(4 * w + ql) * 4 + 2] = mk2; selm[(4 * w + ql) * 4 + 3] = mk3; }
        { unsigned u0 = mk0, u1 = mk1, u2 = mk2, u3 = mk3;
          { auto r = __builtin_amdgcn_permlane16_swap(u0, u0, false, false); u0 = r[0] | r[1]; } { auto r = __builtin_amdgcn_permlane32_swap(u0, u0, false, false); u0 = r[0] | r[1]; }
          { auto r = __builtin_amdgcn_permlane16_swap(u1, u1, false, false); u1 = r[0] | r[1]; } { auto r = __builtin_amdgcn_permlane32_swap(u1, u1, false, false); u1 = r[0] | r[1]; }
          { auto r = __builtin_amdgcn_permlane16_swap(u2, u2, false, false); u2 = r[0] | r[1]; } { auto r = __builtin_amdgcn_permlane32_swap(u2, u2, false, false); u2 = r[0] | r[1]; }
          { auto r = __builtin_amdgcn_permlane16_swap(u3, u3, false, false); u3 = r[0] | r[1]; } { auto r = __builtin_amdgcn_permlane32_swap(u3, u3, false, false); u3 = r[0] | r[1]; }
          if (lane == 0) { uni[16 + 4 * w + 0] = u0; uni[16 + 4 * w + 1] = u1; uni[16 + 4 * w + 2] = u2; uni[16 + 4 * w + 3] = u3; } }
    }
    __syncthreads();
    int wpb = 0;
    {
        unsigned uw0 = 0u, uw1 = 0u, uw2 = 0u, uw3 = 0u;
#pragma unroll
        for (int ww = 0; ww < 8; ++ww) { uw0 |= uni[16 + 4 * ww + 0]; uw1 |= uni[16 + 4 * ww + 1]; uw2 |= uni[16 + 4 * ww + 2]; uw3 |= uni[16 + 4 * ww + 3]; }
        unsigned long long um0 = ((unsigned long long)uw1 << 32) | uw0, um1 = ((unsigned long long)uw3 << 32) | uw2;
        { const int cmx = (t0 + UQ - 1) >> 6; if (cmx < 63) { um0 &= (2ull << cmx) - 1ull; um1 = 0ull; } else if (cmx == 63) { um1 = 0ull; } else if (cmx < 127) { um1 &= (2ull << (cmx - 64)) - 1ull; } }
        um0 = ((unsigned long long)__builtin_amdgcn_readfirstlane((unsigned)(um0 >> 32)) << 32) | (unsigned)__builtin_amdgcn_readfirstlane((unsigned)um0);
        um1 = ((unsigned long long)__builtin_amdgcn_readfirstlane((unsigned)(um1 >> 32)) << 32) | (unsigned)__builtin_amdgcn_readfirstlane((unsigned)um1);
#pragma unroll
        for (int qt = 0; qt < NQT; ++qt) { m[qt] = MFLOOR; l[qt] = 0.f; L[qt] = (f32x4){0.f, 0.f, 0.f, 0.f};
#pragma unroll
            for (int dt = 0; dt < 4; ++dt) O[qt][dt] = (f32x4){0.f, 0.f, 0.f, 0.f}; }
        int jb = 0; um0 &= ~1ull; int bufi = 0;
        for (;;) {
            int jn = -1;
            if (um0) { jn = __builtin_ctzll(um0); um0 &= um0 - 1ull; } else if (um1) { jn = 64 + __builtin_ctzll(um1); um1 &= um1 - 1ull; }
            if (jn < 0) break;
            STG_LOAD(ksl, vsl, NSA_LD, 64 * jn);
            unsigned selbits = 0u;
#pragma unroll
            for (int qt = 0; qt < NQT; ++qt) { const unsigned wv = selm[(2 * NQT * w + qt * 2 + (c >> 3)) * 4 + (jb >> 5)]; selbits |= ((wv >> (jb & 31)) & 1u) << qt; }
            chunk_compute<0, 1, false, true>(KSBUF(bufi), VTBUF(bufi), qf, m, l, O, L, onesf, tq0, sl2, 64 * jb, 1 << 30, selbits, c, quad, imp_rows, 0, linv);
            STG_STORE(bufi ^ 1);
            __syncthreads();
            jb = jn; bufi ^= 1;
        }
        {
            unsigned selbits = 0u;
#pragma unroll
            for (int qt = 0; qt < NQT; ++qt) { const unsigned wv = selm[(2 * NQT * w + qt * 2 + (c >> 3)) * 4 + (jb >> 5)]; selbits |= ((wv >> (jb & 31)) & 1u) << qt; }
            STG_LOAD(kwp, vwp, NSA_LD, t0 - 512 + 64 * c0);
            chunk_compute<0, 1, true, true>(KSBUF(bufi), VTBUF(bufi), qf, m, l, O, L, onesf, tq0, sl2, 64 * jb, 1 << 30, selbits, c, quad, imp_rows, 0, linv);
            STG_STORE(bufi ^ 1);
            __syncthreads();
        }
        wpb = bufi ^ 1;
#pragma unroll
        for (int qt = 0; qt < NQT; ++qt) {
            float lt = L[qt][0]; lt = xsum32(xsum16(lt)); const float sc = (lt > 0.f ? 1.0f / lt : 0.f) * GATE(qt, 1);
            LAS f32x4* ol = (LAS f32x4*)(lds + OACC_OFF) + ((w * NQT + qt) * 4) * 64 + lane;
#pragma unroll
            for (int dt = 0; dt < 4; ++dt) { const f32x4 prev = ol[dt * 64]; ol[dt * 64] = prev + O[qt][dt] * sc; }
        }
    }
    {
#pragma unroll
        for (int qt = 0; qt < NQT; ++qt) { m[qt] = MFLOOR; l[qt] = 0.f; L[qt] = (f32x4){0.f, 0.f, 0.f, 0.f};
#pragma unroll
            for (int dt = 0; dt < 4; ++dt) O[qt][dt] = (f32x4){0.f, 0.f, 0.f, 0.f}; }
#define WIN_ITER(MSK_) do { const int bsel = (ci - c0 + wpb) & 1; STG_LOAD(kwp, vwp, NSA_LD, t0 - 512 + 64 * (ci + 1)); \
            chunk_compute<0, 1, MSK_>(KSBUF(bsel), VTBUF(bsel), qf, m, l, O, L, onesf, tq0, sl2, t0 - 512 + 64 * ci, 512, 0xFu, c, quad, imp_rows, 0, linv); \
            STG_STORE(bsel ^ 1); __syncthreads(); } while (0)
        int ci = c0;
        if (ci < 8) { WIN_ITER(true); ++ci; }
        for (; ci < 8; ++ci) WIN_ITER(false);
#undef WIN_ITER
        chunk_compute<0, 1, true>(KSBUF((8 - c0 + wpb) & 1), VTBUF((8 - c0 + wpb) & 1), qf, m, l, O, L, onesf, tq0, sl2, t0, 512, 0xFu, c, quad, imp_rows, 0, linv);
        __syncthreads();
#pragma unroll
        for (int qt = 0; qt < NQT; ++qt) {
            float lt = L[qt][0]; lt = xsum32(xsum16(lt)); const float sc = (lt > 0.f ? 1.0f / lt : 0.f) * GATE(qt, 2);
            int eoff = (tq0 + 2 * qt) * DM + head * 64 + quad * 4; asm volatile("" : "+v"(eoff));
            LAS const f32x4* ol = (LAS const f32x4*)(lds + OACC_OFF) + ((w * NQT + qt) * 4) * 64 + lane;
            bf16_t* orow = Obuf + (size_t)b * SEQ * DM + eoff;
#pragma unroll
            for (int dt = 0; dt < 4; ++dt) { const f32x4 o = ol[dt * 64] + O[qt][dt] * sc; u32x2 pk; pk.x = pk2(o[0], o[1]); pk.y = pk2(o[2], o[3]); *(u32x2*)(orow + dt * 16) = pk; }
        }
    }
}

constexpr int PH_PER_LAYER = 16;
__device__ __forceinline__ bool phase_exists(int L, int k) {
    if (L >= DEPTH || k > 11) return false;
    if (k == 0) return L == 0;
    if (k >= 2 && k <= 4) return (L & 1) != 0;
    return true;
}
template <int PHM>
__device__ __forceinline__ void run_phases(const Args& a, LAS unsigned char* lds) {
    volatile LAS unsigned* bst = (volatile LAS unsigned*)(lds + 131072 + 64);
    if (threadIdx.x == 0) { bst[0] = 0u; bst[1] = 0u; }
    __syncthreads();
    XcdBarrier xbar = xcd_barrier_post((unsigned*)(a.ws + WS_CTL), bst);
    int rep = 0, nsync = 0;
    for (int ph = a.ph_lo; ph < a.ph_hi; ++ph) {
        int tid = threadIdx.x; asm volatile("" : "+v"(tid));
        int bid = blockIdx.x; asm volatile("" : "+s"(bid));
        int G = gridDim.x; asm volatile("" : "+s"(G));
        size_t zoff = 0; asm volatile("" : "+s"(zoff)); unsigned char* ws = a.ws + zoff;
        const int lane = tid & 63, wave = __builtin_amdgcn_readfirstlane(tid >> 6);
        const int gw = bid * 8 + wave, NGW = G * 8, gtid = bid * 512 + tid, NT = G * 512;
        bf16_t* WIN = (bf16_t*)(ws + WS_WIN); bf16_t* WO = (bf16_t*)(ws + WS_WO); bf16_t* WGU = (bf16_t*)(ws + WS_WGU); bf16_t* WDN = (bf16_t*)(ws + WS_WDN); bf16_t* WC1 = (bf16_t*)(ws + WS_WC1);
        bf16_t* H = (bf16_t*)(ws + WS_H); bf16_t* PROJ = (bf16_t*)(ws + WS_PROJ); bf16_t* OB = (bf16_t*)(ws + WS_O); float* MIX = (float*)(ws + WS_MIX); bf16_t* MIXB = (bf16_t*)(ws + WS_MIX);
        bf16_t* ACMP = (bf16_t*)(ws + WS_ACMP); bf16_t* HID = (bf16_t*)(ws + WS_HID); bf16_t* KVC = (bf16_t*)(ws + WS_KVC); bf16_t* ACT = (bf16_t*)(ws + WS_ACT); bf16_t* SBG0 = (bf16_t*)(ws + WS_GU); bf16_t* SBU0 = SBG0 + (size_t)(MTOK / 64) * 2 * DFF; bf16_t* SBG1 = SBU0 + (size_t)(MTOK / 64) * 2 * DFF;
        const float* norm_g = a.in[1];
        const int L = ph / PH_PER_LAYER, k = ph % PH_PER_LAYER;
        if (!phase_exists(L, k)) continue;
        const int j = L >> 1; const bool nsa = (L & 1) != 0;
        const float* gL = norm_g + (size_t)L * 4 * DM;
#ifndef DUPM
#define DUPM 0
#endif
#ifndef DUPPAR
#define DUPPAR 3
#endif
        const int nrep = (((DUPM >> k) & 1) && ((DUPPAR >> (L & 1)) & 1)) ? 2 : 1;
        const int kk = ((PHM >> k) & 1) ? k : -1;
        switch (kk) {
        case 0: { convert_weights(a, 0, lds, gw, NGW, wave, lane); row_phase(nullptr, a.in[0], nullptr, nullptr, gL, H, gw, NGW, lane); } break;
        case 1: case 6: case 10: {
            pg8::Gemm g; pg8::EpiBf16<0> E; int N;
            if (k == 1) { N = nsa ? NSA_LD : SWA_N; g = pg8::Gemm{H, WIN, MTOK, N, DM}; E = pg8::EpiBf16<0>{PROJ, N, nsa ? nullptr : a.in[3] + (size_t)j * SWA_N}; }
            else if (k == 6) { N = DM; g = pg8::Gemm{OB, WO, MTOK, DM, DM}; E = pg8::EpiBf16<0>{MIXB, DM, nsa ? nullptr : a.in[6] + (size_t)j * DM}; }
            else { N = DM; g = pg8::Gemm{ACT, WDN, MTOK, DM, DFF}; E = pg8::EpiBf16<0>{MIXB, DM, nullptr}; }
            pg8::StaticOrder S; S.init(MTOK, N, G, bid);
            pg8::gemm_phase<pg8::EpiBf16<0>, pg8::StaticOrder, true, true>(lds, g, S, E, tid);
        } break;
        case 8: {
            pg8::Gemm g{H, WGU, MTOK, GU_N, DM};
            pg8::EpiAct E{ACT, DFF, a.in[16] + (size_t)L * 3 * DFF, a.in[17] + (size_t)L * DFF, SBG0, SBU0, SBG1};
            pg8::StaticOrder S; S.init(MTOK, GU_N, G, bid);
            pg8::gemm_phase<pg8::EpiAct, pg8::StaticOrder, true, true>(lds, g, S, E, tid);
        } break;
        case 2: cmp_build(PROJ, a.in[8] + (size_t)j * 2 * 32 * 64, ACMP, gtid, NT); break;
        case 3: {
            for (int kv = 0; kv < 2; ++kv) {
                pg8::Gemm g{ACMP + (size_t)kv * CMP_ROWS * 2048, WC1 + (size_t)kv * 512 * DM, CMP_ROWS, 512, DM};
                pg8::EpiBf16<2> E{HID + (size_t)kv * CMP_ROWS * 512, 512, a.in[10] + (size_t)(j * 2 + kv) * 512};
                pg8::StaticOrder S; S.init(CMP_ROWS, 512, G, (bid + G - 32 * kv) % G);
                pg8::gemm_phase<pg8::EpiBf16<2>, pg8::StaticOrder, true, true>(lds, g, S, E, tid);
            }
        } break;
        case 4: cmp_out(HID, a.in[11] + (size_t)j * 2 * 512 * 64, a.in[12] + (size_t)j * 2 * 64, KVC, lds, tid, gw, NGW); break;
        case 5: {
            for (int r = 0; r * G < NUNIT; ++r) {
                const int R = r * G + ((r & 1) ? (G - 1 - bid) : bid);
                if (R >= NUNIT) continue;
                const int unit = (R & 7) * QBN + (QBN - 1 - (R >> 3));
                if (nsa) nsa_unit(PROJ, KVC, MIX, OB, unit, lds, tid); else swa_unit(PROJ, a.in[4] + (size_t)j * 32, OB, unit, lds, tid);
            }
        } break;
        case 7: row_phase(MIXB, L == 0 ? a.in[0] : a.out, a.out, gL + DM, gL + 2 * DM, H, gw, NGW, lane); break;
        case 9: act_fixup(SBG0, SBU0, SBG1, ACT, a.in[16] + (size_t)L * 3 * DFF, a.in[17] + (size_t)L * DFF, gtid, NT); break;
        case 11: {
            row_phase(MIXB, a.out, a.out, gL + 3 * DM, (L + 1 < DEPTH) ? gL + 4 * DM : nullptr, H, gw, NGW, lane);
            if (L + 1 < DEPTH) { __syncthreads(); convert_weights(a, L + 1, lds, gw, NGW, wave, lane);
                if ((DUPM >> 12) & 1) { __syncthreads(); convert_weights(a, L + 1, lds, gw, NGW, wave, lane); } }
        } break;
        default: break;
        }
        if (a.coop) { bool more = false; for (int p2 = ph + 1; p2 < a.ph_hi; ++p2) if (phase_exists(p2 / PH_PER_LAYER, p2 % PH_PER_LAYER)) { more = true; break; } if (more) { if (a.coop < 0) cg::this_grid().sync(); else xcd_barrier(xbar); ++nsync; } }
        else __syncthreads();
        if (nrep == 2 && rep == 0) { rep = 1; --ph; } else rep = 0;
    }
    if ((DUPM >> 13) & 1) { for (int i = 0; i < 20; ++i) xcd_barrier(xbar); }
}
template <int PHM>
__global__ void __launch_bounds__(512, 2) fwd(Args a) {
    extern __shared__ __attribute__((aligned(16))) unsigned char lds_raw[];
    run_phases<PHM>(a, (LAS unsigned char*)lds_raw);
}

#ifndef ONE_LAUNCH
#define ONE_LAUNCH 1
#endif
constexpr int PHM_ALL = 0xFFF;
#if !ONE_LAUNCH
static const void* phase_kernel(int k) {
    switch (k) {
    case 0: return (const void*)fwd<1 << 0>;
    case 1: case 8: return (const void*)fwd<(1 << 1) | (1 << 8)>;
    case 2: return (const void*)fwd<1 << 2>;
    case 3: return (const void*)fwd<1 << 3>;
    case 4: return (const void*)fwd<1 << 4>;
    case 5: return (const void*)fwd<1 << 5>;
    case 6: case 10: return (const void*)fwd<(1 << 6) | (1 << 10)>;
    case 7: return (const void*)fwd<1 << 7>;
    case 9: return (const void*)fwd<1 << 9>;
    default: return (const void*)fwd<1 << 11>;
    }
}
#endif
extern "C" void kernel_launch(void* const* d_in, const int* in_sizes, int n_in, void* d_out, int out_size, void* d_ws, size_t ws_size, hipStream_t stream) {
    static int grid = 0;
    if (grid == 0) {
        if (n_in != 19 || out_size != MTOK * DM || ws_size < WS_END) { fprintf(stderr, "kernel_launch: unexpected shapes n_in %d out %d ws %zu (need %zu)\n", n_in, out_size, ws_size, (size_t)WS_END); grid = -1; return; }
        int dev = 0, cus = 0, per_cu = 0;
        (void)hipGetDevice(&dev); (void)hipDeviceGetAttribute(&cus, hipDeviceAttributeMultiprocessorCount, dev);
#if ONE_LAUNCH
        if (hipFuncSetAttribute((const void*)fwd<PHM_ALL>, hipFuncAttributeMaxDynamicSharedMemorySize, LDS_BYTES) != hipSuccess) { fprintf(stderr, "kernel_launch: hipFuncSetAttribute failed\n"); grid = -1; return; }
        (void)hipOccupancyMaxActiveBlocksPerMultiprocessor(&per_cu, (const void*)fwd<PHM_ALL>, 512, LDS_BYTES);
#else
        for (int k = 0; k < 12; ++k) if (hipFuncSetAttribute(phase_kernel(k), hipFuncAttributeMaxDynamicSharedMemorySize, LDS_BYTES) != hipSuccess) { fprintf(stderr, "kernel_launch: hipFuncSetAttribute failed\n"); grid = -1; return; }
#endif
        (void)hipGetLastError();
        grid = cus > 0 ? cus : 256;
        fprintf(stderr, "kernel_launch: grid %d (cus %d, per_cu %d), ws %zu\n", grid, cus, per_cu, ws_size);
    }
    if (grid < 0) return;
    Args a{};
    for (int i = 0; i < 19; ++i) a.in[i] = (const float*)d_in[i];
    a.out = (float*)d_out; a.ws = (unsigned char*)d_ws;
#if ONE_LAUNCH
    (void)hipMemsetAsync((char*)d_ws + WS_CTL, 0, CTL_BYTES, stream);
    a.ph_lo = 0; a.ph_hi = DEPTH * PH_PER_LAYER; a.coop = 1;
    void* kargs[] = {&a};
    hipError_t e = hipLaunchCooperativeKernel((const void*)fwd<PHM_ALL>, dim3(grid), dim3(512), kargs, LDS_BYTES, stream);
    if (e != hipSuccess) fprintf(stderr, "cooperative launch failed: %s (grid %d)\n", hipGetErrorString(e), grid);
#else
    for (int ph = 0; ph < DEPTH * PH_PER_LAYER; ++ph) {
        const int L = ph / PH_PER_LAYER, k = ph % PH_PER_LAYER;
        if (L >= DEPTH || k > 11 || (k == 0 && L != 0) || (k >= 2 && k <= 4 && !(L & 1))) continue;
        a.ph_lo = ph; a.ph_hi = ph + 1; a.coop = 0;
        void* kargs[] = {&a};
        hipError_t e = hipLaunchKernel(phase_kernel(k), dim3(grid), dim3(512), kargs, LDS_BYTES, stream);
        if (e != hipSuccess) { fprintf(stderr, "launch failed: %s (phase %d)\n", hipGetErrorString(e), ph); break; }
    }
#endif
}
```

```cpp
#include <hip/hip_runtime.h>
#include <hip/hip_cooperative_groups.h>
#include <cstdio>
#include <cstdint>
namespace cg = cooperative_groups;
namespace pg8 {
#define PG8_LAS __attribute__((address_space(3)))
typedef unsigned short bf16_t;
typedef short bf16x8 __attribute__((ext_vector_type(8)));
typedef float f32x4 __attribute__((ext_vector_type(4)));
typedef unsigned u32x4 __attribute__((ext_vector_type(4)));
constexpr int BM = 256, BK = 64, HALF = 128, HTB = HALF * BK * 2  , STAGE_BYTES = 8 * HTB, NXCD = 8, WGM = 8;

__host__ __device__ __forceinline__ int lds_byte(int r, int c) { const int st = (r >> 4) * 2 + (c >> 5), rr = r & 15, cc = c & 31, ob = rr * 64 + cc * 2; return st * 1024 + (ob ^ (((ob >> 9) & 1) << 5)); }
__host__ __device__ __forceinline__ void stage_rc(int b, int& R, int& C) { const int st = b / 1024, sb = b % 1024, swz = sb ^ (((sb >> 9) & 1) << 5); R = (st >> 1) * 16 + swz / 64; C = (st & 1) * 32 + (swz % 64) / 2; }
__host__ __device__ __forceinline__ int perm32(int rho) { const int n = rho >> 4, i = rho & 15; return 8 * (i >> 2) + 4 * n + (i & 3); }

struct Unit { int pm, pn; };
struct Gemm { const bf16_t* A; const bf16_t* Bt; int M, N, K; };

struct StaticOrder {
    int nM, nN, nwg, G, c;
    __host__ __device__ void init(int M, int N, int G_, int c_) { nM = M / BM; nN = N / BM; nwg = nM * nN; G = G_; c = c_; }
    __host__ __device__ bool next(int i, Unit& u) const {
        const long L = (long)i * G + c; if (L >= nwg) return false;
        int wgid = (int)L; { const int q = nwg / NXCD, r = nwg % NXCD, xcd = wgid % NXCD, off = wgid / NXCD; wgid = (xcd < r ? xcd * (q + 1) : r * (q + 1) + (xcd - r) * q) + off; }
        const int nig = WGM * nN, gid = wgid / nig, fm = gid * WGM, gsz = (nM - fm) < WGM ? (nM - fm) : WGM;
        u.pm = fm + ((wgid % nig) % gsz); u.pn = (wgid % nig) / gsz; return true;
    }
    __device__ __forceinline__ void a_ready(const Unit&) const {}
    __device__ __forceinline__ void done(const Unit&) const {}
};

__device__ __forceinline__ unsigned cvt_pk_bf16(float lo, float hi) { unsigned r; asm volatile("v_cvt_pk_bf16_f32 %0, %1, %2" : "=v"(r) : "v"(lo), "v"(hi)); return r; }
__device__ __forceinline__ float gelu_tanh(float x) { const float u = 0.7978845608028654f * (x + 0.044715f * x * x * x); return x * __builtin_amdgcn_rcpf(1.0f + __builtin_amdgcn_exp2f(-2.0f * 1.4426950408889634f * u)); }
template <int ACT> struct EpiBf16 {
    static constexpr bool PERM = true, AFTER_DRAIN = false;
    bf16_t* O; int ldc; const float* bias;
    __device__ __forceinline__ void operator()(const f32x4 (&acc)[2][2][4][2], const Unit& u, int wr, int wc, int fr, int fq) const {
        const int row0 = u.pm * BM + wr * 64 + fr; const int col0 = u.pn * BM + wc * 32 + 8 * fq;
        f32x4 bv[2][2];
#pragma unroll
        for (int bj = 0; bj < 2; ++bj)
#pragma unroll
            for (int n = 0; n < 2; ++n) bv[bj][n] = bias ? *(const f32x4*)(bias + col0 + bj * HALF + 4 * n) : (f32x4){0.f, 0.f, 0.f, 0.f};
#pragma unroll
        for (int ai = 0; ai < 2; ++ai)
#pragma unroll
            for (int m = 0; m < 4; ++m) { bf16_t* rowp = O + (size_t)(row0 + ai * HALF + m * 16) * ldc + col0;
#pragma unroll
                for (int bj = 0; bj < 2; ++bj) { f32x4 v0 = acc[ai][bj][m][0] + bv[bj][0], v1 = acc[ai][bj][m][1] + bv[bj][1];
                    if (ACT == 2) { v0 = (f32x4){gelu_tanh(v0[0]), gelu_tanh(v0[1]), gelu_tanh(v0[2]), gelu_tanh(v0[3])}; v1 = (f32x4){gelu_tanh(v1[0]), gelu_tanh(v1[1]), gelu_tanh(v1[2]), gelu_tanh(v1[3])}; }
                    u32x4 w; w.x = cvt_pk_bf16(v0[0], v0[1]); w.y = cvt_pk_bf16(v0[2], v0[3]); w.z = cvt_pk_bf16(v1[0], v1[1]); w.w = cvt_pk_bf16(v1[2], v1[3]);
                    *(u32x4*)(rowp + bj * HALF) = w; } }
    }
};
struct EpiF32 {
    static constexpr bool PERM = false, AFTER_DRAIN = false;
    float* O; int ldc; const float* bias;
    __device__ __forceinline__ void operator()(const f32x4 (&acc)[2][2][4][2], const Unit& u, int wr, int wc, int fr, int fq) const {
        const int row0 = u.pm * BM + wr * 64 + fr; const int col0 = u.pn * BM + wc * 32 + 4 * fq;
        f32x4 bv[2][2];
#pragma unroll
        for (int bj = 0; bj < 2; ++bj)
#pragma unroll
            for (int n = 0; n < 2; ++n) bv[bj][n] = bias ? *(const f32x4*)(bias + col0 + bj * HALF + 16 * n) : (f32x4){0.f, 0.f, 0.f, 0.f};
#pragma unroll
        for (int ai = 0; ai < 2; ++ai)
#pragma unroll
            for (int m = 0; m < 4; ++m) { float* rowp = O + (size_t)(row0 + ai * HALF + m * 16) * ldc + col0;
#pragma unroll
                for (int bj = 0; bj < 2; ++bj)
#pragma unroll
                    for (int n = 0; n < 2; ++n) *(f32x4*)(rowp + bj * HALF + 16 * n) = acc[ai][bj][m][n] + bv[bj][n]; }
    }
};

__device__ __forceinline__ float dpp_f(float oldv, float src, const int ctrl_sel) {
    const int o = __builtin_bit_cast(int, oldv), s = __builtin_bit_cast(int, src); int r;
    if (ctrl_sel == 0) r = __builtin_amdgcn_update_dpp(o, s, 0x121, 0xF, 0xF, false);
    else if (ctrl_sel == 1) r = __builtin_amdgcn_update_dpp(o, s, 0x111, 0xF, 0xF, false);
    else if (ctrl_sel == 2) r = __builtin_amdgcn_update_dpp(o, s, 0x122, 0xF, 0xF, false);
    else r = __builtin_amdgcn_update_dpp(o, s, 0x112, 0xF, 0xF, false);
    return __builtin_bit_cast(float, r);
}
struct EpiAct {
    static constexpr bool PERM = true, AFTER_DRAIN = false;
    bf16_t* ACT; int dff; const float* cw; const float* cb; bf16_t* SBG0; bf16_t* SBU0; bf16_t* SBG1;
    __device__ __forceinline__ void operator()(const f32x4 (&acc)[2][2][4][2], const Unit& u, int wr, int wc, int fr, int fq) const {
        const int f0 = u.pn * HALF + wc * 32 + 8 * fq;
        float w0[8], w1[8], w2[8], bb[8];
#pragma unroll
        for (int h = 0; h < 2; ++h) { const f32x4 a0 = *(const f32x4*)(cw + f0 + 4 * h), a1 = *(const f32x4*)(cw + dff + f0 + 4 * h), a2 = *(const f32x4*)(cw + 2 * dff + f0 + 4 * h), a3 = *(const f32x4*)(cb + f0 + 4 * h);
#pragma unroll
            for (int e = 0; e < 4; ++e) { w0[4 * h + e] = a0[e]; w1[4 * h + e] = a1[e]; w2[4 * h + e] = a2[e]; bb[4 * h + e] = a3[e]; } }
#pragma unroll
        for (int ai = 0; ai < 2; ++ai) {
            const int grp = u.pm * 4 + ai * 2 + wr;
            float pg[8];
#pragma unroll
            for (int e = 0; e < 8; ++e) pg[e] = 0.f;
#pragma unroll
            for (int m = 0; m < 4; ++m) {
                float g[8], up[8], o[8];
#pragma unroll
                for (int e = 0; e < 8; ++e) { g[e] = acc[ai][0][m][e >> 2][e & 3]; up[e] = acc[ai][1][m][e >> 2][e & 3]; }
#pragma unroll
                for (int e = 0; e < 8; ++e) {
                    const float t1 = dpp_f(0.f, pg[e], 0); const float g1 = dpp_f(t1, g[e], 1);
                    const float t2 = dpp_f(0.f, pg[e], 2); const float g2 = dpp_f(t2, g[e], 3);
                    const float av = bb[e] + w0[e] * g2 + w1[e] * g1 + w2[e] * g[e];
                    o[e] = av * __builtin_amdgcn_rcpf(1.0f + __builtin_amdgcn_exp2f(-1.4426950408889634f * av)) * up[e];
                }
                const int row = u.pm * BM + ai * HALF + wr * 64 + m * 16 + fr;
                u32x4 ov; ov.x = cvt_pk_bf16(o[0], o[1]); ov.y = cvt_pk_bf16(o[2], o[3]); ov.z = cvt_pk_bf16(o[4], o[5]); ov.w = cvt_pk_bf16(o[6], o[7]);
                *(u32x4*)(ACT + (size_t)row * dff + f0) = ov;
                if (m == 0 && fr < 2) {
                    u32x4 gv; gv.x = cvt_pk_bf16(g[0], g[1]); gv.y = cvt_pk_bf16(g[2], g[3]); gv.z = cvt_pk_bf16(g[4], g[5]); gv.w = cvt_pk_bf16(g[6], g[7]);
                    u32x4 uv; uv.x = cvt_pk_bf16(up[0], up[1]); uv.y = cvt_pk_bf16(up[2], up[3]); uv.z = cvt_pk_bf16(up[4], up[5]); uv.w = cvt_pk_bf16(up[6], up[7]);
                    *(u32x4*)(SBG0 + (size_t)(grp * 2 + fr) * dff + f0) = gv; *(u32x4*)(SBU0 + (size_t)(grp * 2 + fr) * dff + f0) = uv;
                }
                if (m == 3 && fr >= 14) {
                    u32x4 gv; gv.x = cvt_pk_bf16(g[0], g[1]); gv.y = cvt_pk_bf16(g[2], g[3]); gv.z = cvt_pk_bf16(g[4], g[5]); gv.w = cvt_pk_bf16(g[6], g[7]);
                    *(u32x4*)(SBG1 + (size_t)(grp * 2 + fr - 14) * dff + f0) = gv;
                }
#pragma unroll
                for (int e = 0; e < 8; ++e) pg[e] = g[e];
            }
        }
    }
};
template <class Epi, class Sched, bool ALIGN_EPI = false, bool SP2 = false>
__device__ __forceinline__ void gemm_phase(PG8_LAS unsigned char* lds, const Gemm g, const Sched& S, const Epi& E, const int tid) {
    const int wid = __builtin_amdgcn_readfirstlane(tid >> 6), lane = tid & 63, wr = wid >> 2, wc = wid & 3, fr = lane & 15, fq = lane >> 4;
    const int K = g.K, nt = K / BK;
    unsigned voffA[2], voffB[2];
#pragma unroll
    for (int i = 0; i < 2; ++i) { int R, C; stage_rc(tid * 16 + i * 8192, R, C); const int Rb = Epi::PERM ? ((R & ~31) + perm32(R & 31)) : R;
        voffA[i] = (unsigned)(R * K + C) * 2u; voffB[i] = (unsigned)(Rb * K + C) * 2u; }
    const size_t kstep = (size_t)(BK * 2);
    const size_t hstep = (size_t)HALF * K * 2;
    const size_t tstep = 2 * hstep;
    const unsigned ldsw = (unsigned)wid * 1024u;
    const int aoff = lds_byte(wr * 64 + fr, fq * 8), boff = lds_byte(wc * 32 + fr, fq * 8);
#define PG8_SA(b, h) (((b) * 2 + (h)) * HTB)
#define PG8_SB(b, h) ((4 + (b) * 2 + (h)) * HTB)
#define PG8_STAGE(bufoff, gbase, voff) do { _Pragma("unroll") for (int _i = 0; _i < 2; ++_i) \
        __builtin_amdgcn_global_load_lds((const unsigned*)((const char*)(gbase) + (voff)[_i]), (PG8_LAS unsigned*)(lds + (bufoff) + ldsw + _i * 8192), 16, 0, 0); } while (0)
#define PG8_LDA(dst, b, h) do { _Pragma("unroll") for (int m = 0; m < 4; ++m) _Pragma("unroll") for (int k = 0; k < 2; ++k) dst[m][k] = *(const PG8_LAS bf16x8*)(lds + PG8_SA(b, h) + aoff + m * 2048 + k * 1024); } while (0)
#define PG8_LDB(dst, b, h) do { _Pragma("unroll") for (int n = 0; n < 2; ++n) _Pragma("unroll") for (int k = 0; k < 2; ++k) dst[n][k] = *(const PG8_LAS bf16x8*)(lds + PG8_SB(b, h) + boff + n * 2048 + k * 1024); } while (0)
#define PG8_MMA(ai, bj, At, Bt) do { __builtin_amdgcn_s_setprio(1); _Pragma("unroll") for (int m = 0; m < 4; ++m) _Pragma("unroll") for (int n = 0; n < 2; ++n) _Pragma("unroll") for (int k = 0; k < 2; ++k) \
        acc[ai][bj][m][n] = __builtin_amdgcn_mfma_f32_16x16x32_bf16(Bt[n][k], At[m][k], acc[ai][bj][m][n], 0, 0, 0); __builtin_amdgcn_s_setprio(0); } while (0)
#define PG8_WAIT_V(n) asm volatile("s_waitcnt vmcnt(" #n ")" ::: "memory")
#define PG8_WAIT_L(n) asm volatile("s_waitcnt lgkmcnt(" #n ")" ::: "memory")
#define PG8_BAR __builtin_amdgcn_s_barrier()
#define PG8_SCHED __builtin_amdgcn_sched_barrier(0)
    Unit cur, nxt; int ui = 0;
    if (!S.next(0, cur)) return;
    f32x4 acc[2][2][4][2];
#pragma unroll
    for (int a = 0; a < 2; ++a)
#pragma unroll
        for (int b = 0; b < 2; ++b)
#pragma unroll
            for (int m = 0; m < 4; ++m)
#pragma unroll
                for (int n = 0; n < 2; ++n) acc[a][b][m][n] = (f32x4){0.f, 0.f, 0.f, 0.f};
    bf16x8 At[4][2], B0[2][2], B1[2][2];
    const char* cA = (const char*)g.A + (size_t)cur.pm * tstep; const char* cB = (const char*)g.Bt + (size_t)cur.pn * tstep;
    S.a_ready(cur);
    if constexpr (SP2) {
        PG8_STAGE(PG8_SB(0, 0), cB, voffB); PG8_STAGE(PG8_SB(0, 1), cB + hstep, voffB); PG8_STAGE(PG8_SA(0, 0), cA, voffA); PG8_STAGE(PG8_SA(0, 1), cA + hstep, voffA);
        if (wr == 1) PG8_BAR;
        PG8_WAIT_V(2); PG8_BAR;
        PG8_STAGE(PG8_SB(1, 0), cB + kstep, voffB); PG8_STAGE(PG8_SA(1, 0), cA + kstep, voffA); PG8_STAGE(PG8_SB(1, 1), cB + hstep + kstep, voffB);
        PG8_WAIT_V(6); PG8_BAR;
    } else {
        PG8_STAGE(PG8_SB(0, 0), cB, voffB); PG8_STAGE(PG8_SA(0, 0), cA, voffA); PG8_STAGE(PG8_SB(0, 1), cB + hstep, voffB); PG8_STAGE(PG8_SA(0, 1), cA + hstep, voffA);
        if (wr == 1) PG8_BAR;
        PG8_WAIT_V(4); PG8_BAR;
        PG8_STAGE(PG8_SB(1, 0), cB + kstep, voffB); PG8_STAGE(PG8_SA(1, 0), cA + kstep, voffA); PG8_STAGE(PG8_SB(1, 1), cB + hstep + kstep, voffB);
        PG8_WAIT_V(6); PG8_BAR;
    }
    for (;;) {
        const bool has_next = S.next(ui + 1, nxt);
        const char* nA = has_next ? (const char*)g.A + (size_t)nxt.pm * tstep : cA; const char* nB = has_next ? (const char*)g.Bt + (size_t)nxt.pn * tstep : cB;
        for (int t = 0; t < nt; t += 2) {
            const bool last = (t == nt - 2);
            const char* a1 = cA + (size_t)(t + 1) * kstep;
            const char* a2 = last ? nA : cA + (size_t)(t + 2) * kstep; const char* b2 = last ? nB : cB + (size_t)(t + 2) * kstep;
            const char* a3 = a2 + kstep; const char* b3 = b2 + kstep;
            if (last && has_next) S.a_ready(nxt);
            if constexpr (SP2) {
            PG8_LDB(B0, 0, 0); PG8_LDB(B1, 0, 1); PG8_SCHED; PG8_LDA(At, 0, 0); PG8_STAGE(PG8_SA(1, 1), a1 + hstep, voffA);
            PG8_WAIT_V(8); PG8_WAIT_L(0); PG8_BAR; PG8_MMA(0, 0, At, B0); PG8_MMA(0, 1, At, B1); PG8_BAR; PG8_SCHED;
            PG8_LDA(At, 0, 1); PG8_STAGE(PG8_SB(0, 0), b2, voffB); PG8_STAGE(PG8_SB(0, 1), b2 + hstep, voffB); PG8_STAGE(PG8_SA(0, 0), a2, voffA);
            PG8_WAIT_V(8); PG8_WAIT_L(0); PG8_BAR; PG8_MMA(1, 0, At, B0); PG8_MMA(1, 1, At, B1); PG8_BAR; PG8_SCHED;
            PG8_LDB(B0, 1, 0); PG8_LDB(B1, 1, 1); PG8_SCHED; PG8_LDA(At, 1, 0); PG8_STAGE(PG8_SA(0, 1), a2 + hstep, voffA);
            PG8_WAIT_V(8); PG8_WAIT_L(0); PG8_BAR; PG8_MMA(0, 0, At, B0); PG8_MMA(0, 1, At, B1); PG8_BAR; PG8_SCHED;
            PG8_LDA(At, 1, 1); PG8_STAGE(PG8_SB(1, 0), b3, voffB); PG8_STAGE(PG8_SB(1, 1), b3 + hstep, voffB); PG8_STAGE(PG8_SA(1, 0), a3, voffA);
            PG8_WAIT_V(8); PG8_WAIT_L(0); PG8_BAR; PG8_MMA(1, 0, At, B0); PG8_MMA(1, 1, At, B1); PG8_BAR; PG8_SCHED;
            } else {
            PG8_LDB(B0, 0, 0); PG8_SCHED; PG8_LDA(At, 0, 0); PG8_STAGE(PG8_SA(1, 1), a1 + hstep, voffA);
            PG8_WAIT_L(8); PG8_BAR; PG8_WAIT_L(0); PG8_MMA(0, 0, At, B0); PG8_BAR; PG8_SCHED;
            PG8_LDB(B1, 0, 1); PG8_STAGE(PG8_SB(0, 0), b2, voffB);
            PG8_BAR; PG8_WAIT_L(0); PG8_MMA(0, 1, At, B1); PG8_BAR;
            PG8_LDA(At, 0, 1); PG8_STAGE(PG8_SA(0, 0), a2, voffA);
            PG8_BAR; PG8_WAIT_L(0); PG8_MMA(1, 0, At, B0); PG8_BAR; PG8_SCHED;
            PG8_STAGE(PG8_SB(0, 1), b2 + hstep, voffB);
            PG8_WAIT_V(6); PG8_BAR; PG8_MMA(1, 1, At, B1); PG8_BAR;
            PG8_LDB(B0, 1, 0); PG8_SCHED; PG8_LDA(At, 1, 0); PG8_STAGE(PG8_SA(0, 1), a2 + hstep, voffA);
            PG8_WAIT_L(8); PG8_BAR; PG8_WAIT_L(0); PG8_MMA(0, 0, At, B0); PG8_BAR; PG8_SCHED;
            PG8_LDB(B1, 1, 1); PG8_STAGE(PG8_SB(1, 0), b3, voffB);
            PG8_BAR; PG8_WAIT_L(0); PG8_MMA(0, 1, At, B1); PG8_BAR;
            PG8_LDA(At, 1, 1); PG8_STAGE(PG8_SA(1, 0), a3, voffA);
            PG8_BAR; PG8_WAIT_L(0); PG8_MMA(1, 0, At, B0); PG8_BAR; PG8_SCHED;
            PG8_STAGE(PG8_SB(1, 1), b3 + hstep, voffB);
            PG8_WAIT_V(6); PG8_BAR; PG8_MMA(1, 1, At, B1); PG8_BAR;
            }
        }
        if constexpr (ALIGN_EPI) { if (wr == 0) PG8_BAR; }
        if constexpr (!Epi::AFTER_DRAIN) { E(acc, cur, wr, wc, fr, fq); S.done(cur); }
        if (!has_next) break;
#pragma unroll
        for (int a = 0; a < 2; ++a)
#pragma unroll
            for (int b = 0; b < 2; ++b)
#pragma unroll
                for (int m = 0; m < 4; ++m)
#pragma unroll
                    for (int n = 0; n < 2; ++n) acc[a][b][m][n] = (f32x4){0.f, 0.f, 0.f, 0.f};
        cur = nxt; cA = nA; cB = nB; ++ui;
        if constexpr (ALIGN_EPI) { if (wr == 1) PG8_BAR; }
    }
    PG8_WAIT_V(0);
    if constexpr (!ALIGN_EPI) { if (wr == 0) PG8_BAR; }
    PG8_BAR;
    if constexpr (Epi::AFTER_DRAIN) { E.fused(acc, cur, wr, wc, fr, fq, lds, wid, lane); S.done(cur); }
#undef PG8_SA
#undef PG8_SB
#undef PG8_STAGE
#undef PG8_LDA
#undef PG8_LDB
#undef PG8_MMA
#undef PG8_WAIT_V
#undef PG8_WAIT_L
#undef PG8_BAR
#undef PG8_SCHED
}
}

#define LAS __attribute__((address_space(3)))
typedef unsigned short bf16_t;
typedef short bf16x8 __attribute__((ext_vector_type(8)));
typedef short s16x4 __attribute__((ext_vector_type(4)));
typedef float f32x4 __attribute__((ext_vector_type(4)));
typedef unsigned u32x4 __attribute__((ext_vector_type(4)));
typedef unsigned u32x2 __attribute__((ext_vector_type(2)));

constexpr int SEQ = 8192, NBATCH = 2, MTOK = NBATCH * SEQ, DM = 2048, DFF = 5632, DEPTH = 4;
constexpr int SWA_N = 2560, NSA_N = 3680, NSA_LD = 3840, GU_N = 2 * DFF;
constexpr int NCMP = 511, CMP_ROWS = 4096;
constexpr float RMS_EPS = 1e-6f, LOG2E = 1.4426950408889634f, QSC = 0.125f * 1.4426950408889634f;
constexpr size_t MiB = 1u << 20;
constexpr size_t WS_WIN = 0, WS_WO = 16 * MiB, WS_WGU = 24 * MiB, WS_WDN = 68 * MiB, WS_WC1 = 90 * MiB, WS_H = 96 * MiB;
constexpr size_t WS_PROJ = 160 * MiB, WS_O = 280 * MiB, WS_MIX = 344 * MiB, WS_ACMP = 472 * MiB, WS_HID = 504 * MiB, WS_KVC = 512 * MiB;
constexpr size_t WS_CTL = 94 * MiB, CTL_BYTES = 16384;
constexpr size_t WS_GU = 160 * MiB, WS_ACT = 520 * MiB, WS_END = 696 * MiB;
constexpr int ROWE = 80;
constexpr int KS_OFF = 0, KS_BYTES = 64 * ROWE * 2, VT_OFF = 2 * KS_BYTES, VT_BYTES = 64 * ROWE * 2, IMP_OFF = 2 * KS_BYTES + 2 * VT_BYTES, SELM_OFF = IMP_OFF + 16384, UNI_OFF = SELM_OFF + 1024, OACC_OFF = UNI_OFF + 1024;
static_assert(OACC_OFF + 65536 <= 131072, "attention LDS map");
constexpr int LDS_BYTES = 131072 + 1024;

struct Args { const float* in[19]; float* out; unsigned char* ws; int ph_lo, ph_hi, coop, pad; };

__device__ __forceinline__ float bf2f(unsigned short v) { return __uint_as_float(((unsigned)v) << 16); }
__device__ __forceinline__ float bflo(unsigned v) { return __uint_as_float(v << 16); }
__device__ __forceinline__ float bfhi(unsigned v) { return __uint_as_float(v & 0xffff0000u); }
typedef float f32x2_t __attribute__((ext_vector_type(2))); typedef __bf16 bf16x2_t __attribute__((ext_vector_type(2)));
__device__ __forceinline__ unsigned pk2(float lo, float hi) { f32x2_t v = {lo, hi}; bf16x2_t b = __builtin_convertvector(v, bf16x2_t); return __builtin_bit_cast(unsigned, b); }
__device__ __forceinline__ float wave_sum(float v) {
#pragma unroll
    for (int o = 1; o < 64; o <<= 1) v += __shfl_xor(v, o);
    return v;
}


#define GAS __attribute__((address_space(1)))
typedef GAS unsigned gu32;
#define XB_TMO      128
#define XB_XCNT(j)  (256  + 64 * (j))
#define XB_XSUB(j)  (1280 + 64 * (j))
#define XB_XGEN(j)  (2304 + 64 * (j))
#define XB_TOP      3328
#define XB_TOPGEN   3392
#define XCD_BAR_WORDS 3456
#define XB_SPIN_CAP (1u << 18)

__device__ __forceinline__ unsigned xb_ld(unsigned* p)              { return __hip_atomic_load(p, __ATOMIC_RELAXED, __HIP_MEMORY_SCOPE_AGENT); }
__device__ __forceinline__ unsigned xb_add(unsigned* p, unsigned v) { return __hip_atomic_fetch_add(p, v, __ATOMIC_RELAXED, __HIP_MEMORY_SCOPE_AGENT); }
__device__ __forceinline__ unsigned xb_xcc_id() { return (unsigned)__builtin_amdgcn_s_getreg((3 << 11) | 20) & 0xFu; }
#define XB_SPIN(cond, bar) do { unsigned _sp = 0; while (cond) { __builtin_amdgcn_s_sleep(1); \
    if ((++_sp & 255u) == 0u) { if (xb_ld(&(bar)[XB_TMO])) break; if (_sp > XB_SPIN_CAP) { atomicAdd(&(bar)[XB_TMO], 1u); break; } } } } while (0)

struct XcdBarrier {
    unsigned* bar; unsigned x;
    volatile LAS unsigned* st;
};

__device__ __forceinline__ XcdBarrier xcd_barrier_post(unsigned* bar, volatile LAS unsigned* st) {
    XcdBarrier b; b.bar = bar; b.x = xb_xcc_id(); b.st = st;
    if (threadIdx.x == 0) (void)xb_add(&bar[XB_XCNT(b.x)], 1u);
    return b;
}
__device__ __forceinline__ void xcd_barrier_complete(unsigned* bar, unsigned x, unsigned& nloc, unsigned& nx) {
    const unsigned G = gridDim.x * gridDim.y * gridDim.z;
    unsigned sum, cnt, mine, sp = 0u;
    for (;;) {
        sum = 0u; cnt = 0u; mine = 0u;
#pragma unroll
        for (unsigned j = 0; j < 16; ++j) { const unsigned c = xb_ld(&bar[XB_XCNT(j)]); sum += c; cnt += (c > 0u) ? 1u : 0u; mine = (j == x) ? c : mine; }
        if (sum == G) break;
        __builtin_amdgcn_s_sleep(1);
        if ((++sp & 255u) == 0u) { if (xb_ld(&bar[XB_TMO])) break; if (sp > XB_SPIN_CAP) { atomicAdd(&bar[XB_TMO], 1u); break; } }
    }
    nloc = mine > 0u ? mine : 1u; nx = cnt > 0u ? cnt : 1u;
}

__device__ __forceinline__ void xcd_barrier(const XcdBarrier& b) {
    asm volatile("s_waitcnt vmcnt(0)" ::: "memory");
    __syncthreads();
    if (threadIdx.x == 0) {
        unsigned* bar = b.bar;
        __builtin_amdgcn_s_waitcnt(0);
        unsigned nloc = b.st[0], nx = b.st[1];
        if (nloc == 0u) { xcd_barrier_complete(bar, b.x, nloc, nx); b.st[0] = nloc; b.st[1] = nx; }
        const unsigned old = xb_add(&bar[XB_XSUB(b.x)], 1u);
        const unsigned gen = old / nloc;
        if (old + 1u == (gen + 1u) * nloc) {
            __builtin_amdgcn_fence(__ATOMIC_RELEASE, "agent");
            asm volatile("s_waitcnt vmcnt(0)" ::: "memory");
            const unsigned og = xb_add(&bar[XB_TOP], 1u);
            const unsigned tg = og / nx;
            if (og + 1u == (tg + 1u) * nx) xb_add(&bar[XB_TOPGEN], 1u);
            else XB_SPIN(xb_ld(&bar[XB_TOPGEN]) == tg, bar);
            __builtin_amdgcn_fence(__ATOMIC_ACQUIRE, "agent");
            xb_add(&bar[XB_XGEN(b.x)], 1u);
            asm volatile("s_waitcnt vmcnt(0)" ::: "memory");
        } else {
            XB_SPIN(xb_ld(&bar[XB_XGEN(b.x)]) == gen, bar);
            __builtin_amdgcn_fence(__ATOMIC_ACQUIRE, "agent");
            asm volatile("s_waitcnt vmcnt(0)" ::: "memory");
        }
    }
    __syncthreads();
}

__device__ __forceinline__ void transpose_item(const float* W, int K, int N, bf16_t* WT, int ilv, int add, LAS float* scr, int item, int lane) {
    const int nblk = N / 32, kb = item / nblk, nb = item % nblk, k0 = 64 * kb, n0 = 32 * nb;
#pragma unroll
    for (int i = 0; i < 8; ++i) { const int kk = 8 * i + (lane >> 3), n4 = (lane & 7) * 4; const f32x4 v = __builtin_nontemporal_load((const f32x4*)(W + (size_t)(k0 + kk) * N + n0 + n4));
        LAS float* d = scr + kk * 33 + n4; d[0] = v.x; d[1] = v.y; d[2] = v.z; d[3] = v.w; }
    asm volatile("s_waitcnt lgkmcnt(0)" ::: "memory");
    const int c = lane & 7;
#pragma unroll
    for (int j = 0; j < 4; ++j) { const int nl = (lane >> 3) + 8 * j; const LAS float* s = scr + (8 * c) * 33 + nl;
        u32x4 o; o.x = pk2(s[0 * 33], s[1 * 33]); o.y = pk2(s[2 * 33], s[3 * 33]); o.z = pk2(s[4 * 33], s[5 * 33]); o.w = pk2(s[6 * 33], s[7 * 33]);
        const int n = n0 + nl; const int row = ilv ? (((n >> 7) << 8) + (n & 127) + add) : n;
        *(u32x4*)(WT + (size_t)row * K + k0 + 8 * c) = o; }
    asm volatile("s_waitcnt lgkmcnt(0)" ::: "memory");
}
__device__ __forceinline__ void convert_weights(const Args& a, int L, LAS unsigned char* lds, int gw, int NGW, int wave, int lane) {
    LAS float* scr = (LAS float*)(lds + wave * 16384);
    const int j = L >> 1; const bool nsa = (L & 1) != 0;
    const int NIN = nsa ? NSA_N : SWA_N;
    const float* w_in = nsa ? a.in[7] + (size_t)j * DM * NSA_N : a.in[2] + (size_t)j * DM * SWA_N;
    const float* w_o = nsa ? a.in[13] + (size_t)j * DM * DM : a.in[5] + (size_t)j * DM * DM;
    const float* w_g = a.in[14] + (size_t)L * DM * DFF; const float* w_u = a.in[15] + (size_t)L * DM * DFF; const float* w_d = a.in[18] + (size_t)L * DFF * DM;
    const float* w_c = a.in[9] + (size_t)j * 2 * DM * 512;
    bf16_t* WIN = (bf16_t*)(a.ws + WS_WIN); bf16_t* WO = (bf16_t*)(a.ws + WS_WO); bf16_t* WGU = (bf16_t*)(a.ws + WS_WGU); bf16_t* WDN = (bf16_t*)(a.ws + WS_WDN); bf16_t* WC1 = (bf16_t*)(a.ws + WS_WC1);
    const int I0 = 32 * (NIN / 32), I1 = 32 * 64, I2 = 32 * (DFF / 32), I4 = (DFF / 64) * 64, I5 = nsa ? 32 * 16 : 0;
    const int total = I0 + I1 + 2 * I2 + I4 + 2 * I5;
    for (int it = gw; it < total; it += NGW) {
        int r = it;
        if (r < I0) { transpose_item(w_in, DM, NIN, WIN, 0, 0, scr, r, lane); continue; } r -= I0;
        if (r < I1) { transpose_item(w_o, DM, DM, WO, 0, 0, scr, r, lane); continue; } r -= I1;
        if (r < I2) { transpose_item(w_g, DM, DFF, WGU, 1, 0, scr, r, lane); continue; } r -= I2;
        if (r < I2) { transpose_item(w_u, DM, DFF, WGU, 1, 128, scr, r, lane); continue; } r -= I2;
        if (r < I4) { transpose_item(w_d, DFF, DM, WDN, 0, 0, scr, r, lane); continue; } r -= I4;
        if (r < I5) { transpose_item(w_c, DM, 512, WC1, 0, 0, scr, r, lane); continue; } r -= I5;
        transpose_item(w_c + (size_t)DM * 512, DM, 512, WC1 + (size_t)512 * DM, 0, 0, scr, r, lane);
    }
}

__device__ __forceinline__ void row_phase(const bf16_t* mix, const float* xsrc, float* xdst, const float* gA, const float* gB, bf16_t* H, int gw, int NGW, int lane) {
    f32x4 ga[8], gb[8];
#pragma unroll
    for (int j = 0; j < 8; ++j) { ga[j] = mix ? ((const f32x4*)gA)[lane + 64 * j] : (f32x4){0.f, 0.f, 0.f, 0.f}; gb[j] = gB ? ((const f32x4*)gB)[lane + 64 * j] : (f32x4){0.f, 0.f, 0.f, 0.f}; }
    for (int row = gw; row < MTOK; row += NGW) {
        const f32x4* xr = (const f32x4*)(xsrc + (size_t)row * DM) + lane;
        f32x4 xv[8];
#pragma unroll
        for (int j = 0; j < 8; ++j) xv[j] = __builtin_nontemporal_load(&xr[64 * j]);
        if (mix) {
            const u32x2* mr = (const u32x2*)(mix + (size_t)row * DM) + lane;
            f32x4 mv[8]; float ss = 0.f;
#pragma unroll
            for (int j = 0; j < 8; ++j) { const u32x2 mb = __builtin_nontemporal_load(&mr[64 * j]); mv[j] = (f32x4){bflo(mb.x), bfhi(mb.x), bflo(mb.y), bfhi(mb.y)}; ss += (mv[j].x * mv[j].x + mv[j].y * mv[j].y) + (mv[j].z * mv[j].z + mv[j].w * mv[j].w); }
            const float r1 = 1.0f / sqrtf(wave_sum(ss) * (1.0f / DM) + RMS_EPS);
            f32x4* xo = (f32x4*)(xdst + (size_t)row * DM) + lane;
#pragma unroll
            for (int j = 0; j < 8; ++j) { const f32x4 g = ga[j]; xv[j] = xv[j] + mv[j] * r1 * g; __builtin_nontemporal_store(xv[j], &xo[64 * j]); }
        }
        if (gB) {
            float ss = 0.f;
#pragma unroll
            for (int j = 0; j < 8; ++j) ss += (xv[j].x * xv[j].x + xv[j].y * xv[j].y) + (xv[j].z * xv[j].z + xv[j].w * xv[j].w);
            const float r2 = 1.0f / sqrtf(wave_sum(ss) * (1.0f / DM) + RMS_EPS);
            u32x2* ho = (u32x2*)(H + (size_t)row * DM) + lane;
#pragma unroll
            for (int j = 0; j < 8; ++j) { const f32x4 g = gb[j]; const f32x4 h = xv[j] * r2 * g; u32x2 o; o.x = pk2(h.x, h.y); o.y = pk2(h.z, h.w); ho[64 * j] = o; }
        }
    }
}

__device__ __forceinline__ void act_phase(const bf16_t* GU, bf16_t* ACT, const float* cw, const float* cb, int gtid, int nthreads) {
    constexpr int NFC = DFF / 8, NRB = MTOK / 16;
    for (int it = gtid; it < NFC * NRB; it += nthreads) {
        const int fc = it % NFC, rb = it / NFC, f0 = fc * 8, r0 = rb * 16;
        const int gcol = ((f0 >> 7) << 8) + (f0 & 127);
        float w0[8], w1[8], w2[8], bb[8];
#pragma unroll
        for (int e = 0; e < 8; ++e) { w0[e] = cw[f0 + e]; w1[e] = cw[DFF + f0 + e]; w2[e] = cw[2 * DFF + f0 + e]; bb[e] = cb[f0 + e]; }
        float g2[8], g1[8];
        const bool has_prev = (r0 & (SEQ - 1)) != 0;
        {
            u32x4 a2 = (u32x4){0, 0, 0, 0}, a1 = (u32x4){0, 0, 0, 0};
            if (has_prev) { a2 = *(const u32x4*)(GU + (size_t)(r0 - 2) * GU_N + gcol); a1 = *(const u32x4*)(GU + (size_t)(r0 - 1) * GU_N + gcol); }
            g2[0] = bflo(a2.x); g2[1] = bfhi(a2.x); g2[2] = bflo(a2.y); g2[3] = bfhi(a2.y); g2[4] = bflo(a2.z); g2[5] = bfhi(a2.z); g2[6] = bflo(a2.w); g2[7] = bfhi(a2.w);
            g1[0] = bflo(a1.x); g1[1] = bfhi(a1.x); g1[2] = bflo(a1.y); g1[3] = bfhi(a1.y); g1[4] = bflo(a1.z); g1[5] = bfhi(a1.z); g1[6] = bflo(a1.w); g1[7] = bfhi(a1.w);
        }
#pragma unroll 4
        for (int i = 0; i < 16; ++i) {
            const u32x4 gv = *(const u32x4*)(GU + (size_t)(r0 + i) * GU_N + gcol);
            const u32x4 uv = *(const u32x4*)(GU + (size_t)(r0 + i) * GU_N + gcol + 128);
            float g0[8], up[8], o[8];
            g0[0] = bflo(gv.x); g0[1] = bfhi(gv.x); g0[2] = bflo(gv.y); g0[3] = bfhi(gv.y); g0[4] = bflo(gv.z); g0[5] = bfhi(gv.z); g0[6] = bflo(gv.w); g0[7] = bfhi(gv.w);
            up[0] = bflo(uv.x); up[1] = bfhi(uv.x); up[2] = bflo(uv.y); up[3] = bfhi(uv.y); up[4] = bflo(uv.z); up[5] = bfhi(uv.z); up[6] = bflo(uv.w); up[7] = bfhi(uv.w);
#pragma unroll
            for (int e = 0; e < 8; ++e) { const float av = bb[e] + w0[e] * g2[e] + w1[e] * g1[e] + w2[e] * g0[e];
                o[e] = av * __builtin_amdgcn_rcpf(1.0f + __builtin_amdgcn_exp2f(-LOG2E * av)) * up[e]; g2[e] = g1[e]; g1[e] = g0[e]; }
            u32x4 ov; ov.x = pk2(o[0], o[1]); ov.y = pk2(o[2], o[3]); ov.z = pk2(o[4], o[5]); ov.w = pk2(o[6], o[7]);
            *(u32x4*)(ACT + (size_t)(r0 + i) * DFF + f0) = ov;
        }
    }
}


__device__ __forceinline__ void act_fixup(const bf16_t* SBG0, const bf16_t* SBU0, const bf16_t* SBG1, bf16_t* ACT, const float* cw, const float* cb, int gtid, int nthreads) {
    constexpr int NFC = DFF / 8, NGRP = MTOK / 64;
    for (int it = gtid; it < NFC * NGRP * 2; it += nthreads) {
        const int fc = it % NFC, gr = it / NFC, r = gr & 1, grp = gr >> 1, f0 = fc * 8;
        const bool has_prev = (grp % (SEQ / 64)) != 0;
        const u32x4 z = (u32x4){0, 0, 0, 0};
        const u32x4 own0 = *(const u32x4*)(SBG0 + (size_t)(grp * 2 + 0) * DFF + f0), own1 = *(const u32x4*)(SBG0 + (size_t)(grp * 2 + 1) * DFF + f0);
        const u32x4 upv = *(const u32x4*)(SBU0 + (size_t)(grp * 2 + r) * DFF + f0);
        const u32x4 p62 = has_prev ? *(const u32x4*)(SBG1 + (size_t)((grp - 1) * 2 + 0) * DFF + f0) : z, p63 = has_prev ? *(const u32x4*)(SBG1 + (size_t)((grp - 1) * 2 + 1) * DFF + f0) : z;
        const u32x4 a2 = r ? p63 : p62, a1 = r ? own0 : p63, a0 = r ? own1 : own0;
        float g2[8], g1[8], g0[8], up[8], o[8];
        g2[0] = bflo(a2.x); g2[1] = bfhi(a2.x); g2[2] = bflo(a2.y); g2[3] = bfhi(a2.y); g2[4] = bflo(a2.z); g2[5] = bfhi(a2.z); g2[6] = bflo(a2.w); g2[7] = bfhi(a2.w);
        g1[0] = bflo(a1.x); g1[1] = bfhi(a1.x); g1[2] = bflo(a1.y); g1[3] = bfhi(a1.y); g1[4] = bflo(a1.z); g1[5] = bfhi(a1.z); g1[6] = bflo(a1.w); g1[7] = bfhi(a1.w);
        g0[0] = bflo(a0.x); g0[1] = bfhi(a0.x); g0[2] = bflo(a0.y); g0[3] = bfhi(a0.y); g0[4] = bflo(a0.z); g0[5] = bfhi(a0.z); g0[6] = bflo(a0.w); g0[7] = bfhi(a0.w);
        up[0] = bflo(upv.x); up[1] = bfhi(upv.x); up[2] = bflo(upv.y); up[3] = bfhi(upv.y); up[4] = bflo(upv.z); up[5] = bfhi(upv.z); up[6] = bflo(upv.w); up[7] = bfhi(upv.w);
        float wb[8], w0[8], w1[8], w2[8];
#pragma unroll
        for (int h = 0; h < 2; ++h) { const f32x4 a0 = *(const f32x4*)(cb + f0 + 4 * h), a1 = *(const f32x4*)(cw + f0 + 4 * h), a2 = *(const f32x4*)(cw + DFF + f0 + 4 * h), a3 = *(const f32x4*)(cw + 2 * DFF + f0 + 4 * h);
#pragma unroll
            for (int e = 0; e < 4; ++e) { wb[4 * h + e] = a0[e]; w0[4 * h + e] = a1[e]; w1[4 * h + e] = a2[e]; w2[4 * h + e] = a3[e]; } }
#pragma unroll
        for (int e = 0; e < 8; ++e) { const float av = wb[e] + w0[e] * g2[e] + w1[e] * g1[e] + w2[e] * g0[e];
            o[e] = av * __builtin_amdgcn_rcpf(1.0f + __builtin_amdgcn_exp2f(-LOG2E * av)) * up[e]; }
        u32x4 ov; ov.x = pk2(o[0], o[1]); ov.y = pk2(o[2], o[3]); ov.z = pk2(o[4], o[5]); ov.w = pk2(o[6], o[7]);
        *(u32x4*)(ACT + (size_t)(grp * 64 + r) * DFF + f0) = ov;
    }
}
__device__ __forceinline__ void cmp_build(const bf16_t* PROJ, const float* pe  , bf16_t* ACMP, int gtid, int nthreads) {
    for (int it = gtid; it < 2 * CMP_ROWS * 256; it += nthreads) {
        const int piece = it & 255, row = (it >> 8) & (CMP_ROWS - 1), kv = it >> 20;
        u32x4 o = (u32x4){0, 0, 0, 0};
        if (row < NBATCH * NCMP * 4) {
            const int g = row & 3, bn = row >> 2, n = bn % NCMP, b = bn / NCMP, l = piece >> 3, d0 = (piece & 7) * 8;
            const u32x4 s = *(const u32x4*)(PROJ + (size_t)(b * SEQ + 16 * n + l) * NSA_LD + 2048 + kv * 256 + g * 64 + d0);
            const f32x4 p0 = *(const f32x4*)(pe + (kv * 32 + l) * 64 + d0), p1 = *(const f32x4*)(pe + (kv * 32 + l) * 64 + d0 + 4);
            o.x = pk2(bflo(s.x) + p0.x, bfhi(s.x) + p0.y); o.y = pk2(bflo(s.y) + p0.z, bfhi(s.y) + p0.w);
            o.z = pk2(bflo(s.z) + p1.x, bfhi(s.z) + p1.y); o.w = pk2(bflo(s.w) + p1.z, bfhi(s.w) + p1.w);
        }
        *(u32x4*)(ACMP + ((size_t)kv * CMP_ROWS + row) * 2048 + piece * 8) = o;
    }
}
__device__ __forceinline__ void cmp_out(const bf16_t* HID, const float* w2  , const float* b2  , bf16_t* KVC, LAS unsigned char* lds, int tid, int gw, int NGW) {
    LAS float* wl = (LAS float*)lds;
    const int lane = tid & 63;
    for (int kv = 0; kv < 2; ++kv) {
        __syncthreads();
        for (int i = tid; i < 512 * 64 / 4; i += 512) ((LAS f32x4*)wl)[i] = ((const f32x4*)(w2 + (size_t)kv * 512 * 64))[i];
        __syncthreads();
        const float bias = b2[kv * 64 + lane];
        for (int r = gw; r < 2 * 4 * 512; r += NGW) {
            const int n = r & 511, g = (r >> 9) & 3, b = r >> 11;
            float acc = 0.f;
            if (n < NCMP) {
                const int row = (b * NCMP + n) * 4 + g;
                const u32x4* hp = (const u32x4*)(HID + ((size_t)kv * CMP_ROWS + row) * 512);
                float a0 = bias, a1 = 0.f, a2 = 0.f, a3 = 0.f;
#pragma unroll 4
                for (int c8 = 0; c8 < 64; ++c8) { const u32x4 h = hp[c8]; const LAS float* w = wl + c8 * 8 * 64 + lane;
                    a0 += bflo(h.x) * w[0] + bfhi(h.x) * w[64]; a1 += bflo(h.y) * w[128] + bfhi(h.y) * w[192]; a2 += bflo(h.z) * w[256] + bfhi(h.z) * w[320]; a3 += bflo(h.w) * w[384] + bfhi(h.w) * w[448]; }
                acc = (a0 + a1) + (a2 + a3);
            }
            KVC[((size_t)kv * 4096 + r) * 64 + lane] = (bf16_t)(pk2(acc, 0.f) & 0xffffu);
        }
    }
    __syncthreads();
}

constexpr float MFLOOR = -3.0e4f;

__device__ __forceinline__ float xmax16(float v) { auto r = __builtin_amdgcn_permlane16_swap(__float_as_uint(v), __float_as_uint(v), false, false); return fmaxf(__uint_as_float(r[0]), __uint_as_float(r[1])); }
__device__ __forceinline__ float xmax32(float v) { auto r = __builtin_amdgcn_permlane32_swap(__float_as_uint(v), __float_as_uint(v), false, false); return fmaxf(__uint_as_float(r[0]), __uint_as_float(r[1])); }
__device__ __forceinline__ float xsum16(float v) { auto r = __builtin_amdgcn_permlane16_swap(__float_as_uint(v), __float_as_uint(v), false, false); return __uint_as_float(r[0]) + __uint_as_float(r[1]); }
__device__ __forceinline__ float xsum32(float v) { auto r = __builtin_amdgcn_permlane32_swap(__float_as_uint(v), __float_as_uint(v), false, false); return __uint_as_float(r[0]) + __uint_as_float(r[1]); }
template <int CTRL> __device__ __forceinline__ float dppf(float v) { return __int_as_float(__builtin_amdgcn_update_dpp(0, __float_as_int(v), CTRL, 0xF, 0xF, true)); }
template <int CTRL> __device__ __forceinline__ int dppi(int v) { return __builtin_amdgcn_update_dpp(0, v, CTRL, 0xF, 0xF, true); }
constexpr int DPP_X1 = 0xB1  , DPP_X2 = 0x4E  , DPP_HM = 0x141  , DPP_RM = 0x140  ;
constexpr int NQT = 2, UQ = 16 * NQT, NUNIT = MTOK * 4 / UQ, QBN = SEQ / UQ;
template <int MODE, int KSTRIDE, bool MASKED = true, bool SEL = false>
__device__ __forceinline__ void chunk_compute(LAS const unsigned char* Ks, LAS const unsigned char* Vt, const bf16x8 (&qf)[NQT][2], float (&m)[NQT], float (&l)[NQT], f32x4 (&O)[NQT][4], f32x4 (&L)[NQT], const bf16x8 onesf,
                                              int tq0, float sl2, int kp0, int W, unsigned selbits, int c, int quad,
                                              volatile LAS float* imp_rows, int jb0, const float (&linv)[NQT]) {
    int dbase = tq0 - kp0 - quad * 4 * KSTRIDE;
    asm volatile("" : "+v"(dbase));
    bf16x8 kf[4][2];
#pragma unroll
    for (int kt = 0; kt < 4; ++kt)
#pragma unroll
        for (int ks = 0; ks < 2; ++ks) kf[kt][ks] = *(LAS const bf16x8*)(Ks + ((kt * 16 + c) * ROWE + ks * 32 + quad * 8) * 2);
    bf16x8 pb[NQT][2]; bool act[NQT];
#pragma unroll
    for (int qt = 0; qt < NQT; ++qt) {
        const bool selq = ((selbits >> qt) & 1u) != 0u;
        act[qt] = SEL ? (__any(selq ? 1 : 0) != 0) : true;
        pb[qt][0] = (bf16x8){0, 0, 0, 0, 0, 0, 0, 0}; pb[qt][1] = pb[qt][0];
        if (!act[qt]) continue;
        f32x4 s[4];
        const int dq = dbase + 2 * qt; const float bbq = (MASKED || selq) ? -sl2 * (float)dq : -1e30f;
#pragma unroll
        for (int kt = 0; kt < 4; ++kt) {
            s[kt] = (f32x4){__builtin_fmaf(sl2, (float)((kt * 16 + 0) * KSTRIDE), bbq), __builtin_fmaf(sl2, (float)((kt * 16 + 1) * KSTRIDE), bbq), __builtin_fmaf(sl2, (float)((kt * 16 + 2) * KSTRIDE), bbq), __builtin_fmaf(sl2, (float)((kt * 16 + 3) * KSTRIDE), bbq)};
#pragma unroll
            for (int ks = 0; ks < 2; ++ks) s[kt] = __builtin_amdgcn_mfma_f32_16x16x32_bf16(kf[kt][ks], qf[qt][ks], s[kt], 0, 0, 0);
        }
        float mx = -1e30f;
        const int tqq = tq0 + 2 * qt;
        const unsigned lim = selq ? (unsigned)(W < tqq + 1 ? W : tqq + 1) : 0u;
#pragma unroll
        for (int kt = 0; kt < 4; ++kt)
#pragma unroll
            for (int j = 0; j < 4; ++j) {
                const int C = (kt * 16 + j) * KSTRIDE;
                float v = s[kt][j];
                if (MASKED) { const bool valid = (unsigned)(dq - C) < lim; v = valid ? v : -1e30f; }
                s[kt][j] = v; mx = fmaxf(mx, v);
            }
        if (MODE != 2) {
            mx = xmax32(xmax16(mx));
            const float mnew = fmaxf(m[qt], mx); const float alpha = __builtin_amdgcn_exp2f(m[qt] - mnew); m[qt] = mnew;
            float psum = 0.f;
#pragma unroll
            for (int kt = 0; kt < 4; ++kt)
#pragma unroll
                for (int j = 0; j < 4; ++j) { const float p = __builtin_amdgcn_exp2f(s[kt][j] - mnew); s[kt][j] = p; psum += p; }
            if (MODE == 1) l[qt] = l[qt] * alpha + psum;
            if (MODE == 0) {
                L[qt] = L[qt] * alpha;
#pragma unroll
                for (int dt = 0; dt < 4; ++dt) O[qt][dt] = O[qt][dt] * alpha;
            }
        } else {
#pragma unroll
            for (int kt = 0; kt < 4; ++kt)
#pragma unroll
                for (int j = 0; j < 4; ++j) { const float p = __builtin_amdgcn_exp2f(s[kt][j] - m[qt]) * linv[qt]; s[kt][j] = p; }
#pragma unroll
            for (int kt = 0; kt < 4; ++kt) {
                f32x4 hs = s[kt];
#pragma unroll
                for (int j = 0; j < 4; ++j) { hs[j] += dppf<DPP_X1>(hs[j]); hs[j] += dppf<DPP_X2>(hs[j]); hs[j] += dppf<DPP_HM>(hs[j]); }
                if ((c & 7) == 0) {
                    const int ql = qt * 2 + (c >> 3); const int jb = jb0 + kt * 4 + quad;
                    LAS float* p0 = (LAS float*)imp_rows + ql * 128 + jb;
                    (void)__hip_atomic_fetch_add(p0, (hs[0] + hs[1]) + (hs[2] + hs[3]), __ATOMIC_RELAXED, __HIP_MEMORY_SCOPE_WORKGROUP);
                    if (jb + 1 < 128) (void)__hip_atomic_fetch_add(p0 + 1, hs[3], __ATOMIC_RELAXED, __HIP_MEMORY_SCOPE_WORKGROUP);
                }
            }
        }
        if (MODE != 1) {
#pragma unroll
            for (int i = 0; i < 2; ++i) {
                u32x4 w; w.x = pk2(s[2 * i][0], s[2 * i][1]); w.y = pk2(s[2 * i][2], s[2 * i][3]); w.z = pk2(s[2 * i + 1][0], s[2 * i + 1][1]); w.w = pk2(s[2 * i + 1][2], s[2 * i + 1][3]);
                pb[qt][i] = __builtin_bit_cast(bf16x8, w);
            }
        }
    }
    if (MODE != 1) {
        bf16x8 vf[4][2];
#pragma unroll
        for (int dt = 0; dt < 4; ++dt)
#pragma unroll
            for (int i = 0; i < 2; ++i) {
                vf[dt][i] = *(LAS const bf16x8*)(Vt + ((dt * 16 + c) * ROWE + ((32 * i + quad * 8) ^ (dt * 16))) * 2);
            }
#pragma unroll
        for (int qt = 0; qt < NQT; ++qt) {
            if (!act[qt]) continue;
#pragma unroll
            for (int dt = 0; dt < 4; ++dt)
#pragma unroll
                for (int i = 0; i < 2; ++i) O[qt][dt] = __builtin_amdgcn_mfma_f32_16x16x32_bf16(vf[dt][i], pb[qt][i], O[qt][dt], 0, 0, 0);
            if (MODE == 0) {
#pragma unroll
                for (int i = 0; i < 2; ++i) L[qt] = __builtin_amdgcn_mfma_f32_16x16x32_bf16(onesf, pb[qt][i], L[qt], 0, 0, 0);
            }
        }
    }
}

__device__ __forceinline__ bf16x8 scale_q(bf16x8 q) {
    const u32x4 u = __builtin_bit_cast(u32x4, q); u32x4 o;
    o.x = pk2(bflo(u.x) * QSC, bfhi(u.x) * QSC); o.y = pk2(bflo(u.y) * QSC, bfhi(u.y) * QSC); o.z = pk2(bflo(u.z) * QSC, bfhi(u.z) * QSC); o.w = pk2(bflo(u.w) * QSC, bfhi(u.w) * QSC);
    return __builtin_bit_cast(bf16x8, o);
}
#define STG_LOAD(kp_, vp_, ld_, row_) do { const int rr_ = (row_) + (tid >> 3); if (rr_ >= 0 && rr_ < SEQ) { kreg = *(const u32x4*)((kp_) + (size_t)rr_ * (ld_) + (tid & 7) * 8); vreg = *(const u32x4*)((vp_) + (size_t)rr_ * (ld_) + (tid & 7) * 8); } \
        else { kreg = (u32x4){0, 0, 0, 0}; vreg = (u32x4){0, 0, 0, 0}; } } while (0)
#define STG_STORE(buf_) do { *(LAS u32x4*)(lds + KS_OFF + (buf_) * KS_BYTES + (tid >> 3) * (ROWE * 2) + (tid & 7) * 16) = kreg; \
        const int key_ = tid >> 3, pos_ = ((key_ & ~31) + ((key_ >> 2) & 3) * 8 + ((key_ >> 4) & 1) * 4 + (key_ & 3)) ^ (((tid & 7) >> 1) << 4);         \
        LAS bf16_t* vt_ = (LAS bf16_t*)(lds + VT_OFF + (buf_) * VT_BYTES) + ((tid & 7) * 8) * ROWE + pos_; \
        vt_[0 * ROWE] = (bf16_t)(vreg.x & 0xffffu); vt_[1 * ROWE] = (bf16_t)(vreg.x >> 16); vt_[2 * ROWE] = (bf16_t)(vreg.y & 0xffffu); vt_[3 * ROWE] = (bf16_t)(vreg.y >> 16); \
        vt_[4 * ROWE] = (bf16_t)(vreg.z & 0xffffu); vt_[5 * ROWE] = (bf16_t)(vreg.z >> 16); vt_[6 * ROWE] = (bf16_t)(vreg.w & 0xffffu); vt_[7 * ROWE] = (bf16_t)(vreg.w >> 16); } while (0)
#define KSBUF(b_) ((LAS const unsigned char*)(lds + KS_OFF + (b_) * KS_BYTES))
#define VTBUF(b_) ((LAS const unsigned char*)(lds + VT_OFF + (b_) * VT_BYTES))

__device__ __forceinline__ void swa_unit(const bf16_t* PROJ, const float* sinks, bf16_t* Obuf, int unit, LAS unsigned char* lds, const int tid) {
    const int lane = tid & 63, w = tid >> 6, c = lane & 15, quad = lane >> 4;
    const int qb = unit % QBN, kvh = (unit / QBN) & 3, b = unit / (4 * QBN), t0 = qb * UQ;
    const int head = kvh * 8 + (c & 7);
    const float sl2 = __builtin_amdgcn_exp2f(-0.25f * (float)(head + 1)) * LOG2E;
    const bf16_t* base = PROJ + (size_t)b * SEQ * SWA_N;
    const bf16_t* kp = base + 2048 + kvh * 64; const bf16_t* vp = base + 2304 + kvh * 64;
    bf16x8 qf[NQT][2]; float m[NQT], l[NQT], linv[NQT]; f32x4 O[NQT][4]; f32x4 L[NQT];
    const bf16x8 onesf = (c == 0) ? (bf16x8){0x3F80, 0x3F80, 0x3F80, 0x3F80, 0x3F80, 0x3F80, 0x3F80, 0x3F80} : (bf16x8){0, 0, 0, 0, 0, 0, 0, 0};
    const int tq0 = t0 + 2 * NQT * w + (c >> 3);
    const float sink2 = sinks[head] * LOG2E;
#pragma unroll
    for (int qt = 0; qt < NQT; ++qt) {
        m[qt] = sink2; l[qt] = 0.f; linv[qt] = 0.f; L[qt] = (f32x4){(quad == 0) ? 1.0f : 0.0f, 0.f, 0.f, 0.f};
#pragma unroll
        for (int ks = 0; ks < 2; ++ks) qf[qt][ks] = scale_q(__builtin_nontemporal_load((const bf16x8*)(base + (size_t)(tq0 + 2 * qt) * SWA_N + head * 64 + ks * 32 + quad * 8)));
#pragma unroll
        for (int dt = 0; dt < 4; ++dt) O[qt][dt] = (f32x4){0.f, 0.f, 0.f, 0.f};
    }
    u32x4 kreg, vreg;
    STG_LOAD(kp, vp, SWA_N, t0 - 128); STG_STORE(0); __syncthreads();
    for (int ci = 0; ci < 3; ++ci) {
        if (ci + 1 < 3) STG_LOAD(kp, vp, SWA_N, t0 - 128 + 64 * (ci + 1));
        chunk_compute<0, 1>(KSBUF(ci & 1), VTBUF(ci & 1), qf, m, l, O, L, onesf, tq0, sl2, t0 - 128 + 64 * ci, 128, 0xFu, c, quad, nullptr, 0, linv);
        if (ci + 1 < 3) STG_STORE((ci + 1) & 1);
        __syncthreads();
    }
#pragma unroll
    for (int qt = 0; qt < NQT; ++qt) {
        float lt = L[qt][0]; lt = xsum32(xsum16(lt));
        const float inv = 1.0f / lt;
        bf16_t* orow = Obuf + (size_t)(b * SEQ + (tq0 + 2 * qt)) * DM + head * 64 + quad * 4;
#pragma unroll
        for (int dt = 0; dt < 4; ++dt) { const f32x4 o = O[qt][dt] * inv; u32x2 pk; pk.x = pk2(o[0], o[1]); pk.y = pk2(o[2], o[3]); *(u32x2*)(orow + dt * 16) = pk; }
    }
}

#define GATE(qt_, i_) __builtin_amdgcn_rcpf(1.0f + __builtin_amdgcn_exp2f(-LOG2E * gatev[qt_][i_]))
__device__ __forceinline__ void nsa_unit(const bf16_t* PROJ, const bf16_t* KVC, float* OACC, bf16_t* Obuf, int unit, LAS unsigned char* lds, const int tid) {
    const int lane = tid & 63, w = tid >> 6, c = lane & 15, quad = lane >> 4;
    const int qb = unit % QBN, g = (unit / QBN) & 3, b = unit / (4 * QBN), t0 = qb * UQ;
    const int head = g * 8 + (c & 7);
    const float sl2 = __builtin_amdgcn_exp2f(-0.25f * (float)(head + 1)) * LOG2E;
    const bf16_t* base = PROJ + (size_t)b * SEQ * NSA_LD;
    volatile LAS float* imp_rows = (volatile LAS float*)(lds + IMP_OFF) + (2 * NQT * w) * 128;
    volatile LAS unsigned* selm = (volatile LAS unsigned*)(lds + SELM_OFF);
    volatile LAS unsigned* uni = (volatile LAS unsigned*)(lds + UNI_OFF);
    bf16x8 qf[NQT][2]; float m[NQT], l[NQT], linv[NQT]; f32x4 O[NQT][4]; f32x4 L[NQT];
    const bf16x8 onesf = (c == 0) ? (bf16x8){0x3F80, 0x3F80, 0x3F80, 0x3F80, 0x3F80, 0x3F80, 0x3F80, 0x3F80} : (bf16x8){0, 0, 0, 0, 0, 0, 0, 0};
    const int tq0 = t0 + 2 * NQT * w + (c >> 3);
#pragma unroll
    for (int qt = 0; qt < NQT; ++qt) {
        const bf16_t* prow = base + (size_t)(tq0 + 2 * qt) * NSA_LD;
#pragma unroll
        for (int ks = 0; ks < 2; ++ks) qf[qt][ks] = scale_q(__builtin_nontemporal_load((const bf16x8*)(prow + head * 64 + ks * 32 + quad * 8)));
    }
    for (int i = lane; i < 2 * NQT * 128; i += 64) imp_rows[i] = 0.f;
    float gatev[NQT][3];
#pragma unroll
    for (int qt = 0; qt < NQT; ++qt)
#pragma unroll
        for (int i = 0; i < 3; ++i) gatev[qt][i] = bf2f(base[(size_t)(tq0 + 2 * qt) * NSA_LD + 3584 + head * 3 + i]);
    u32x4 kreg, vreg;
    const bf16_t* kc = KVC + ((size_t)((0 * 2 + b) * 4 + g) * 512) * 64; const bf16_t* vc = KVC + ((size_t)((1 * 2 + b) * 4 + g) * 512) * 64;
    const int nmax = (t0 + UQ - 1 - 31) >> 4, ncc = (nmax >> 6) + 1;
    const bf16_t* ksl = base + 2560 + g * 64; const bf16_t* vsl = base + 2816 + g * 64;
    const bf16_t* kwp = base + 3072 + g * 64; const bf16_t* vwp = base + 3328 + g * 64;
    const int c0 = (t0 >= 512) ? 0 : (512 - t0) / 64;
#pragma unroll
    for (int qt = 0; qt < NQT; ++qt) { m[qt] = MFLOOR; l[qt] = 0.f; linv[qt] = 0.f; L[qt] = (f32x4){0.f, 0.f, 0.f, 0.f}; }
    STG_LOAD(kc, vc, 64, 0); STG_STORE(0); __syncthreads();
    {
        const int nun = (t0 >= 1039) ? (t0 - 1039) / 1024 + 1 : 0;
        int ci = 0;
        for (; ci < nun; ++ci) {
            STG_LOAD(kc, vc, 64, 64 * (ci + 1));
            chunk_compute<1, 16, false>(KSBUF(ci & 1), VTBUF(ci & 1), qf, m, l, O, L, onesf, tq0, sl2, 16 * (64 * ci) + 31, 1 << 30, 0xFu, c, quad, imp_rows, 0, linv);
            STG_STORE((ci + 1) & 1);
            __syncthreads();
        }
        for (; ci < ncc; ++ci) {
            STG_LOAD(kc, vc, 64, (ci + 1 < ncc) ? 64 * (ci + 1) : 0);
            chunk_compute<1, 16, true>(KSBUF(ci & 1), VTBUF(ci & 1), qf, m, l, O, L, onesf, tq0, sl2, 16 * (64 * ci) + 31, 1 << 30, 0xFu, c, quad, imp_rows, 0, linv);
            STG_STORE((ci + 1) & 1);
            __syncthreads();
        }
    }
#pragma unroll
    for (int qt = 0; qt < NQT; ++qt) {
        float lt = l[qt]; lt = xsum32(xsum16(lt)); linv[qt] = lt > 0.f ? 1.0f / lt : 0.f;
#pragma unroll
        for (int dt = 0; dt < 4; ++dt) O[qt][dt] = (f32x4){0.f, 0.f, 0.f, 0.f};
    }
    {
        const int nun = (t0 >= 1039) ? (t0 - 1039) / 1024 + 1 : 0;
        const int pb = ncc & 1;
        int ci = 0;
        for (; ci < nun; ++ci) {
            STG_LOAD(kc, vc, 64, 64 * (ci + 1));
            chunk_compute<2, 16, false>(KSBUF((ci + pb) & 1), VTBUF((ci + pb) & 1), qf, m, l, O, L, onesf, tq0, sl2, 16 * (64 * ci) + 31, 1 << 30, 0xFu, c, quad, imp_rows, 16 * ci, linv);
            STG_STORE((ci + 1 + pb) & 1);
            __syncthreads();
        }
        for (; ci < ncc; ++ci) {
            if (ci + 1 < ncc) STG_LOAD(kc, vc, 64, 64 * (ci + 1)); else STG_LOAD(ksl, vsl, NSA_LD, 0);
            chunk_compute<2, 16, true>(KSBUF((ci + pb) & 1), VTBUF((ci + pb) & 1), qf, m, l, O, L, onesf, tq0, sl2, 16 * (64 * ci) + 31, 1 << 30, 0xFu, c, quad, imp_rows, 16 * ci, linv);
            STG_STORE((ci + 1 + pb) & 1);
            __syncthreads();
        }
    }
#pragma unroll
    for (int qt = 0; qt < NQT; ++qt) {
        LAS f32x4* ol = (LAS f32x4*)(lds + OACC_OFF) + ((w * NQT + qt) * 4) * 64 + lane;
#pragma unroll
        for (int dt = 0; dt < 4; ++dt) ol[dt * 64] = O[qt][dt] * GATE(qt, 0);
    }
    {
        const int ql = lane >> 4, sub = lane & 15; const int cur = (t0 + 4 * w + ql) >> 6;
        float v[8];
#pragma unroll
        for (int i = 0; i < 8; ++i) { const int jb = sub + 16 * i; const float x = imp_rows[ql * 128 + jb]; const bool forced = (jb == 0) || (jb == cur) || (jb == cur - 1); v[i] = forced ? -2.0f : (jb <= cur ? x : -1.0f); }
        unsigned mk0 = 1u, mk1 = 0u, mk2 = 0u, mk3 = 0u;
        { const int wd = cur >> 5; const unsigned bit = 1u << (cur & 31); mk0 |= (wd == 0) ? bit : 0u; mk1 |= (wd == 1) ? bit : 0u; mk2 |= (wd == 2) ? bit : 0u; mk3 |= (wd == 3) ? bit : 0u; }
        if (cur >= 1) { const int pj = cur - 1; const int wd = pj >> 5; const unsigned bit = 1u << (pj & 31); mk0 |= (wd == 0) ? bit : 0u; mk1 |= (wd == 1) ? bit : 0u; mk2 |= (wd == 2) ? bit : 0u; mk3 |= (wd == 3) ? bit : 0u; }
        const int nforced = (cur >= 2) ? 3 : cur + 1;
        for (int round = nforced; round < 16; ++round) {
            float bv = v[0]; int bi = sub;
#pragma unroll
            for (int i = 1; i < 8; ++i) if (v[i] > bv) { bv = v[i]; bi = sub + 16 * i; }
            { float ov = dppf<DPP_X1>(bv); int oi = dppi<DPP_X1>(bi); if (ov > bv || (ov == bv && oi < bi)) { bv = ov; bi = oi; }
              ov = dppf<DPP_X2>(bv); oi = dppi<DPP_X2>(bi); if (ov > bv || (ov == bv && oi < bi)) { bv = ov; bi = oi; }
              ov = dppf<DPP_HM>(bv); oi = dppi<DPP_HM>(bi); if (ov > bv || (ov == bv && oi < bi)) { bv = ov; bi = oi; }
              ov = dppf<DPP_RM>(bv); oi = dppi<DPP_RM>(bi); if (ov > bv || (ov == bv && oi < bi)) { bv = ov; bi = oi; } }
            if (!__any(bv >= 0.f ? 1 : 0)) break;
            if (bv >= 0.f) { const unsigned bit = 1u << (bi & 31); const int wd = bi >> 5; mk0 |= (wd == 0) ? bit : 0u; mk1 |= (wd == 1) ? bit : 0u; mk2 |= (wd == 2) ? bit : 0u; mk3 |= (wd == 3) ? bit : 0u;
#pragma unroll
                for (int i = 0; i < 8; ++i) if (bi == sub + 16 * i) v[i] = -2.0f; }
        }
        if (sub == 0) { selm[(4 * w + ql) * 4 + 0] = mk0; selm[(4 * w + ql) * 4 + 1] = mk1; selm[(4 * w + ql) * 4 + 2] = mk2; selm[(4 * w + ql) * 4 + 3] = mk3; }
        { unsigned u0 = mk0, u1 = mk1, u2 = mk2, u3 = mk3;
          { auto r = __builtin_amdgcn_permlane16_swap(u0, u0, false, false); u0 = r[0] | r[1]; } { auto r = __builtin_amdgcn_permlane32_swap(u0, u0, false, false); u0 = r[0] | r[1]; }
          { auto r = __builtin_amdgcn_permlane16_swap(u1, u1, false, false); u1 = r[0] | r[1]; } { auto r = __builtin_amdgcn_permlane32_swap(u1, u1, false, false); u1 = r[0] | r[1]; }
          { auto r = __builtin_amdgcn_permlane16_swap(u2, u2, false, false); u2 = r[0] | r[1]; } { auto r = __builtin_amdgcn_permlane32_swap(u2, u2, false, false); u2 = r[0] | r[1]; }
          { auto r = __builtin_amdgcn_permlane16_swap(u3, u3, false, false); u3 = r[0] | r[1]; } { auto r = __builtin_amdgcn_permlane32_swap(u3, u3, false, false); u3 = r[0] | r[1]; }
          if (lane == 0) { uni[16 + 4 * w + 0] = u0; uni[16 + 4 * w + 1] = u1; uni[16 + 4 * w + 2] = u2; uni[16 + 4 * w + 3] = u3; } }
    }
    __syncthreads();
    int wpb = 0;
    {
        unsigned uw0 = 0u, uw1 = 0u, uw2 = 0u, uw3 = 0u;
#pragma unroll
        for (int ww = 0; ww < 8; ++ww) { uw0 |= uni[16 + 4 * ww + 0]; uw1 |= uni[16 + 4 * ww + 1]; uw2 |= uni[16 + 4 * ww + 2]; uw3 |= uni[16 + 4 * ww + 3]; }
        unsigned long long um0 = ((unsigned long long)uw1 << 32) | uw0, um1 = ((unsigned long long)uw3 << 32) | uw2;
        { const int cmx = (t0 + UQ - 1) >> 6; if (cmx < 63) { um0 &= (2ull << cmx) - 1ull; um1 = 0ull; } else if (cmx == 63) { um1 = 0ull; } else if (cmx < 127) { um1 &= (2ull << (cmx - 64)) - 1ull; } }
        um0 = ((unsigned long long)__builtin_amdgcn_readfirstlane((unsigned)(um0 >> 32)) << 32) | (unsigned)__builtin_amdgcn_readfirstlane((unsigned)um0);
        um1 = ((unsigned long long)__builtin_amdgcn_readfirstlane((unsigned)(um1 >> 32)) << 32) | (unsigned)__builtin_amdgcn_readfirstlane((unsigned)um1);
#pragma unroll
        for (int qt = 0; qt < NQT; ++qt) { m[qt] = MFLOOR; l[qt] = 0.f; L[qt] = (f32x4){0.f, 0.f, 0.f, 0.f};
#pragma unroll
            for (int dt = 0; dt < 4; ++dt) O[qt][dt] = (f32x4){0.f, 0.f, 0.f, 0.f}; }
        int jb = 0; um0 &= ~1ull; int bufi = 0;
        for (;;) {
            int jn = -1;
            if (um0) { jn = __builtin_ctzll(um0); um0 &= um0 - 1ull; } else if (um1) { jn = 64 + __builtin_ctzll(um1); um1 &= um1 - 1ull; }
            if (jn < 0) break;
            STG_LOAD(ksl, vsl, NSA_LD, 64 * jn);
            unsigned selbits = 0u;
#pragma unroll
            for (int qt = 0; qt < NQT; ++qt) { const unsigned wv = selm[(2 * NQT * w + qt * 2 + (c >> 3)) * 4 + (jb >> 5)]; selbits |= ((wv >> (jb & 31)) & 1u) << qt; }
            chunk_compute<0, 1, false, true>(KSBUF(bufi), VTBUF(bufi), qf, m, l, O, L, onesf, tq0, sl2, 64 * jb, 1 << 30, selbits, c, quad, imp_rows, 0, linv);
            STG_STORE(bufi ^ 1);
            __syncthreads();
            jb = jn; bufi ^= 1;
        }
        {
            unsigned selbits = 0u;
#pragma unroll
            for (int qt = 0; qt < NQT; ++qt) { const unsigned wv = selm[(2 * NQT * w + qt * 2 + (c >> 3)) * 4 + (jb >> 5)]; selbits |= ((wv >> (jb & 31)) & 1u) << qt; }
            STG_LOAD(kwp, vwp, NSA_LD, t0 - 512 + 64 * c0);
            chunk_compute<0, 1, true, true>(KSBUF(bufi), VTBUF(bufi), qf, m, l, O, L, onesf, tq0, sl2, 64 * jb, 1 << 30, selbits, c, quad, imp_rows, 0, linv);
            STG_STORE(bufi ^ 1);
            __syncthreads();
        }
        wpb = bufi ^ 1;
#pragma unroll
        for (int qt = 0; qt < NQT; ++qt) {
            float lt = L[qt][0]; lt = xsum32(xsum16(lt)); const float sc = (lt > 0.f ? 1.0f / lt : 0.f) * GATE(qt, 1);
            LAS f32x4* ol = (LAS f32x4*)(lds + OACC_OFF) + ((w * NQT + qt) * 4) * 64 + lane;
#pragma unroll
            for (int dt = 0; dt < 4; ++dt) { const f32x4 prev = ol[dt * 64]; ol[dt * 64] = prev + O[qt][dt] * sc; }
        }
    }
    {
#pragma unroll
        for (int qt = 0; qt < NQT; ++qt) { m[qt] = MFLOOR; l[qt] = 0.f; L[qt] = (f32x4){0.f, 0.f, 0.f, 0.f};
#pragma unroll
            for (int dt = 0; dt < 4; ++dt) O[qt][dt] = (f32x4){0.f, 0.f, 0.f, 0.f}; }
#define WIN_ITER(MSK_) do { const int bsel = (ci - c0 + wpb) & 1; STG_LOAD(kwp, vwp, NSA_LD, t0 - 512 + 64 * (ci + 1)); \
            chunk_compute<0, 1, MSK_>(KSBUF(bsel), VTBUF(bsel), qf, m, l, O, L, onesf, tq0, sl2, t0 - 512 + 64 * ci, 512, 0xFu, c, quad, imp_rows, 0, linv); \
            STG_STORE(bsel ^ 1); __syncthreads(); } while (0)
        int ci = c0;
        if (ci < 8) { WIN_ITER(true); ++ci; }
        for (; ci < 8; ++ci) WIN_ITER(false);
#undef WIN_ITER
        chunk_compute<0, 1, true>(KSBUF((8 - c0 + wpb) & 1), VTBUF((8 - c0 + wpb) & 1), qf, m, l, O, L, onesf, tq0, sl2, t0, 512, 0xFu, c, quad, imp_rows, 0, linv);
        __syncthreads();
#pragma unroll
        for (int qt = 0; qt < NQT; ++qt) {
            float lt = L[qt][0]; lt = xsum32(xsum16(lt)); const float sc = (lt > 0.f ? 1.0f / lt : 0.f) * GATE(qt, 2);
            int eoff = (tq0 + 2 * qt) * DM + head * 64 + quad * 4; asm volatile("" : "+v"(eoff));
            LAS const f32x4* ol = (LAS const f32x4*)(lds + OACC_OFF) + ((w * NQT + qt) * 4) * 64 + lane;
            bf16_t* orow = Obuf + (size_t)b * SEQ * DM + eoff;
#pragma unroll
            for (int dt = 0; dt < 4; ++dt) { const f32x4 o = ol[dt * 64] + O[qt][dt] * sc; u32x2 pk; pk.x = pk2(o[0], o[1]); pk.y = pk2(o[2], o[3]); *(u32x2*)(orow + dt * 16) = pk; }
        }
    }
}

constexpr int PH_PER_LAYER = 16;
__device__ __forceinline__ bool phase_exists(int L, int k) {
    if (L >= DEPTH || k > 11) return false;
    if (k == 0) return L == 0;
    if (k >= 2 && k <= 4) return (L & 1) != 0;
    return true;
}
template <int PHM>
__device__ __forceinline__ void run_phases(const Args& a, LAS unsigned char* lds) {
    volatile LAS unsigned* bst = (volatile LAS unsigned*)(lds + 131072 + 64);
    if (threadIdx.x == 0) { bst[0] = 0u; bst[1] = 0u; }
    __syncthreads();
    XcdBarrier xbar = xcd_barrier_post((unsigned*)(a.ws + WS_CTL), bst);
    int rep = 0, nsync = 0;
    for (int ph = a.ph_lo; ph < a.ph_hi; ++ph) {
        int tid = threadIdx.x; asm volatile("" : "+v"(tid));
        int bid = blockIdx.x; asm volatile("" : "+s"(bid));
        int G = gridDim.x; asm volatile("" : "+s"(G));
        size_t zoff = 0; asm volatile("" : "+s"(zoff)); unsigned char* ws = a.ws + zoff;
        const int lane = tid & 63, wave = __builtin_amdgcn_readfirstlane(tid >> 6);
        const int gw = bid * 8 + wave, NGW = G * 8, gtid = bid * 512 + tid, NT = G * 512;
        bf16_t* WIN = (bf16_t*)(ws + WS_WIN); bf16_t* WO = (bf16_t*)(ws + WS_WO); bf16_t* WGU = (bf16_t*)(ws + WS_WGU); bf16_t* WDN = (bf16_t*)(ws + WS_WDN); bf16_t* WC1 = (bf16_t*)(ws + WS_WC1);
        bf16_t* H = (bf16_t*)(ws + WS_H); bf16_t* PROJ = (bf16_t*)(ws + WS_PROJ); bf16_t* OB = (bf16_t*)(ws + WS_O); float* MIX = (float*)(ws + WS_MIX); bf16_t* MIXB = (bf16_t*)(ws + WS_MIX);
        bf16_t* ACMP = (bf16_t*)(ws + WS_ACMP); bf16_t* HID = (bf16_t*)(ws + WS_HID); bf16_t* KVC = (bf16_t*)(ws + WS_KVC); bf16_t* ACT = (bf16_t*)(ws + WS_ACT); bf16_t* SBG0 = (bf16_t*)(ws + WS_GU); bf16_t* SBU0 = SBG0 + (size_t)(MTOK / 64) * 2 * DFF; bf16_t* SBG1 = SBU0 + (size_t)(MTOK / 64) * 2 * DFF;
        const float* norm_g = a.in[1];
        const int L = ph / PH_PER_LAYER, k = ph % PH_PER_LAYER;
        if (!phase_exists(L, k)) continue;
        const int j = L >> 1; const bool nsa = (L & 1) != 0;
        const float* gL = norm_g + (size_t)L * 4 * DM;
#ifndef DUPM
#define DUPM 0
#endif
#ifndef DUPPAR
#define DUPPAR 3
#endif
        const int nrep = (((DUPM >> k) & 1) && ((DUPPAR >> (L & 1)) & 1)) ? 2 : 1;
        const int kk = ((PHM >> k) & 1) ? k : -1;
        switch (kk) {
        case 0: { convert_weights(a, 0, lds, gw, NGW, wave, lane); row_phase(nullptr, a.in[0], nullptr, nullptr, gL, H, gw, NGW, lane); } break;
        case 1: case 6: case 10: {
            pg8::Gemm g; pg8::EpiBf16<0> E; int N;
            if (k == 1) { N = nsa ? NSA_LD : SWA_N; g = pg8::Gemm{H, WIN, MTOK, N, DM}; E = pg8::EpiBf16<0>{PROJ, N, nsa ? nullptr : a.in[3] + (size_t)j * SWA_N}; }
            else if (k == 6) { N = DM; g = pg8::Gemm{OB, WO, MTOK, DM, DM}; E = pg8::EpiBf16<0>{MIXB, DM, nsa ? nullptr : a.in[6] + (size_t)j * DM}; }
            else { N = DM; g = pg8::Gemm{ACT, WDN, MTOK, DM, DFF}; E = pg8::EpiBf16<0>{MIXB, DM, nullptr}; }
            pg8::StaticOrder S; S.init(MTOK, N, G, bid);
            pg8::gemm_phase<pg8::EpiBf16<0>, pg8::StaticOrder, true, true>(lds, g, S, E, tid);
        } break;
        case 8: {
            pg8::Gemm g{H, WGU, MTOK, GU_N, DM};
            pg8::EpiAct E{ACT, DFF, a.in[16] + (size_t)L * 3 * DFF, a.in[17] + (size_t)L * DFF, SBG0, SBU0, SBG1};
            pg8::StaticOrder S; S.init(MTOK, GU_N, G, bid);
            pg8::gemm_phase<pg8::EpiAct, pg8::StaticOrder, true, true>(lds, g, S, E, tid);
        } break;
        case 2: cmp_build(PROJ, a.in[8] + (size_t)j * 2 * 32 * 64, ACMP, gtid, NT); break;
        case 3: {
            for (int kv = 0; kv < 2; ++kv) {
                pg8::Gemm g{ACMP + (size_t)kv * CMP_ROWS * 2048, WC1 + (size_t)kv * 512 * DM, CMP_ROWS, 512, DM};
                pg8::EpiBf16<2> E{HID + (size_t)kv * CMP_ROWS * 512, 512, a.in[10] + (size_t)(j * 2 + kv) * 512};
                pg8::StaticOrder S; S.init(CMP_ROWS, 512, G, (bid + G - 32 * kv) % G);
                pg8::gemm_phase<pg8::EpiBf16<2>, pg8::StaticOrder, true, true>(lds, g, S, E, tid);
            }
        } break;
        case 4: cmp_out(HID, a.in[11] + (size_t)j * 2 * 512 * 64, a.in[12] + (size_t)j * 2 * 64, KVC, lds, tid, gw, NGW); break;
        case 5: {
            for (int r = 0; r * G < NUNIT; ++r) {
                const int R = r * G + ((r & 1) ? (G - 1 - bid) : bid);
                if (R >= NUNIT) continue;
                const int unit = (R & 7) * QBN + (QBN - 1 - (R >> 3));
                if (nsa) nsa_unit(PROJ, KVC, MIX, OB, unit, lds, tid); else swa_unit(PROJ, a.in[4] + (size_t)j * 32, OB, unit, lds, tid);
            }
        } break;
        case 7: row_phase(MIXB, L == 0 ? a.in[0] : a.out, a.out, gL + DM, gL + 2 * DM, H, gw, NGW, lane); break;
        case 9: act_fixup(SBG0, SBU0, SBG1, ACT, a.in[16] + (size_t)L * 3 * DFF, a.in[17] + (size_t)L * DFF, gtid, NT); break;
        case 11: {
            row_phase(MIXB, a.out, a.out, gL + 3 * DM, (L + 1 < DEPTH) ? gL + 4 * DM : nullptr, H, gw, NGW, lane);
            if (L + 1 < DEPTH) { __syncthreads(); convert_weights(a, L + 1, lds, gw, NGW, wave, lane);
                if ((DUPM >> 12) & 1) { __syncthreads(); convert_weights(a, L + 1, lds, gw, NGW, wave, lane); } }
        } break;
        default: break;
        }
        if (a.coop) { bool more = false; for (int p2 = ph + 1; p2 < a.ph_hi; ++p2) if (phase_exists(p2 / PH_PER_LAYER, p2 % PH_PER_LAYER)) { more = true; break; } if (more) { if (a.coop < 0) cg::this_grid().sync(); else xcd_barrier(xbar); ++nsync; } }
        else __syncthreads();
        if (nrep == 2 && rep == 0) { rep = 1; --ph; } else rep = 0;
    }
    if ((DUPM >> 13) & 1) { for (int i = 0; i < 20; ++i) xcd_barrier(xbar); }
}
template <int PHM>
__global__ void __launch_bounds__(512, 2) fwd(Args a) {
    extern __shared__ __attribute__((aligned(16))) unsigned char lds_raw[];
    run_phases<PHM>(a, (LAS unsigned char*)lds_raw);
}

#ifndef ONE_LAUNCH
#define ONE_LAUNCH 1
#endif
constexpr int PHM_ALL = 0xFFF;
#if !ONE_LAUNCH
static const void* phase_kernel(int k) {
    switch (k) {
    case 0: return (const void*)fwd<1 << 0>;
    case 1: case 8: return (const void*)fwd<(1 << 1) | (1 << 8)>;
    case 2: return (const void*)fwd<1 << 2>;
    case 3: return (const void*)fwd<1 << 3>;
    case 4: return (const void*)fwd<1 << 4>;
    case 5: return (const void*)fwd<1 << 5>;
    case 6: case 10: return (const void*)fwd<(1 << 6) | (1 << 10)>;
    case 7: return (const void*)fwd<1 << 7>;
    case 9: return (const void*)fwd<1 << 9>;
    default: return (const void*)fwd<1 << 11>;
    }
}
#endif
extern "C" void kernel_launch(void* const* d_in, const int* in_sizes, int n_in, void* d_out, int out_size, void* d_ws, size_t ws_size, hipStream_t stream) {
    static int grid = 0;
    if (grid == 0) {
        if (n_in != 19 || out_size != MTOK * DM || ws_size < WS_END) { fprintf(stderr, "kernel_launch: unexpected shapes n_in %d out %d ws %zu (need %zu)\n", n_in, out_size, ws_size, (size_t)WS_END); grid = -1; return; }
        int dev = 0, cus = 0, per_cu = 0;
        (void)hipGetDevice(&dev); (void)hipDeviceGetAttribute(&cus, hipDeviceAttributeMultiprocessorCount, dev);
#if ONE_LAUNCH
        if (hipFuncSetAttribute((const void*)fwd<PHM_ALL>, hipFuncAttributeMaxDynamicSharedMemorySize, LDS_BYTES) != hipSuccess) { fprintf(stderr, "kernel_launch: hipFuncSetAttribute failed\n"); grid = -1; return; }
        (void)hipOccupancyMaxActiveBlocksPerMultiprocessor(&per_cu, (const void*)fwd<PHM_ALL>, 512, LDS_BYTES);
#else
        for (int k = 0; k < 12; ++k) if (hipFuncSetAttribute(phase_kernel(k), hipFuncAttributeMaxDynamicSharedMemorySize, LDS_BYTES) != hipSuccess) { fprintf(stderr, "kernel_launch: hipFuncSetAttribute failed\n"); grid = -1; return; }
#endif
        (void)hipGetLastError();
        grid = cus > 0 ? cus : 256;
        fprintf(stderr, "kernel_launch: grid %d (cus %d, per_cu %d), ws %zu\n", grid, cus, per_cu, ws_size);
    }
    if (grid < 0) return;
    Args a{};
    for (int i = 0; i < 19; ++i) a.in[i] = (const float*)d_in[i];
    a.out = (float*)d_out; a.ws = (unsigned char*)d_ws;
#if ONE_LAUNCH
    (void)hipMemsetAsync((char*)d_ws + WS_CTL, 0, CTL_BYTES, stream);
    a.ph_lo = 0; a.ph_hi = DEPTH * PH_PER_LAYER; a.coop = 1;
    void* kargs[] = {&a};
    hipError_t e = hipLaunchCooperativeKernel((const void*)fwd<PHM_ALL>, dim3(grid), dim3(512), kargs, LDS_BYTES, stream);
    if (e != hipSuccess) fprintf(stderr, "cooperative launch failed: %s (grid %d)\n", hipGetErrorString(e), grid);
#else
    for (int ph = 0; ph < DEPTH * PH_PER_LAYER; ++ph) {
        const int L = ph / PH_PER_LAYER, k = ph % PH_PER_LAYER;
        if (L >= DEPTH || k > 11 || (k == 0 && L != 0) || (k >= 2 && k <= 4 && !(L & 1))) continue;
        a.ph_lo = ph; a.ph_hi = ph + 1; a.coop = 0;
        void* kargs[] = {&a};
        hipError_t e = hipLaunchKernel(phase_kernel(k), dim3(grid), dim3(512), kargs, LDS_BYTES, stream);
        if (e != hipSuccess) { fprintf(stderr, "launch failed: %s (phase %d)\n", hipGetErrorString(e), ph); break; }
    }
#endif
}
```
